# Optimizing an MI355X kernel written in HIP

```python
import math
import jax, jax.numpy as jnp
from jax import lax
import numpy as np

D_MODEL = 1024
BATCH = 2
SEQ = 16384
DEPTH = 2
DEC_BATCH = 32
DEC_SEQ = 64
PAST_LEN = 4096

CHUNK = 64
Q_BLOCK = 128
N_A_LAYERS = max(1, DEPTH // 2)
N_B_LAYERS = DEPTH - N_A_LAYERS
HGRN_EXPAND = 128
H_A = D_MODEL // HGRN_EXPAND
DK_A = HGRN_EXPAND
DV_A = D_MODEL // H_A
D_A = H_A * DK_A
H_B = 8
DH_B = D_MODEL // (2 * H_B)
N_KV_B = 4
G_B = H_B // N_KV_B
ROT_DIM = DH_B // 4
ROPE_THETA = 500000.0
LAMBDA_INIT_SCALE = 0.3
D_FF = 4 * D_MODEL
EPS = 1e-6

kernel_name = "yoco_hgrn2_diffattn_stream_step"


def rms_norm(x, gain):
    xf = x.astype(jnp.float32)
    y = xf * lax.rsqrt(jnp.mean(xf * xf, axis=-1, keepdims=True) + EPS)
    return (y * gain.astype(jnp.float32)).astype(x.dtype)


def squared_relu_mlp(h, w_up, w_down):
    u = jax.nn.relu(h @ w_up)
    return (u * u) @ w_down


def hgrn2_chunk_step(S, blk):
    q, k, v, g = blk
    C = q.shape[1]
    b = jnp.cumsum(g, axis=1)
    causal = jnp.tril(jnp.ones((C, C), dtype=bool))
    diff = b[:, :, None] - b[:, None, :]
    decay = jnp.where(causal[None, :, :, None, None], jnp.exp(jnp.minimum(diff, 0.0)), 0.0)
    scores = jnp.einsum('bthd,btshd,bshd->bhts', q, decay, k)
    o = (jnp.einsum('bhts,bshv->bthv', scores, v)
         + jnp.einsum('bthd,bhdv->bthv', q * jnp.exp(b), S))
    b_last = b[:, -1]
    S = (jnp.exp(b_last)[..., None] * S
         + jnp.einsum('bshd,bshv->bhdv', k * jnp.exp(b_last[:, None] - b), v))
    return S, o


def hgrn2_mixer(h, S0, w_in, lb, g_gain, w_out):
    B, L, _ = h.shape
    q, f, i, gate = jnp.split(h @ w_in, 4, axis=-1)
    forget = lb + (1.0 - lb) * jax.nn.sigmoid(f.astype(jnp.float32))
    heads = lambda t, d: t.reshape(B, L, H_A, d)
    q = heads(jax.nn.silu(q.astype(jnp.float32)) * DK_A ** -0.5, DK_A)
    k = heads(1.0 - forget, DK_A)
    g = heads(jnp.log(forget), DK_A)
    v = heads(i.astype(jnp.float32), DV_A)
    C = min(CHUNK, L)
    n = L // C
    to_blocks = lambda t: t.reshape(B, n, C, H_A, t.shape[-1]).transpose(1, 0, 2, 3, 4)
    S, o = lax.scan(hgrn2_chunk_step, S0.astype(jnp.float32),
                    (to_blocks(q), to_blocks(k), to_blocks(v), to_blocks(g)))
    o = o.transpose(1, 0, 2, 3, 4).reshape(B, L, H_A, DV_A)
    o = rms_norm(o, g_gain) * jax.nn.silu(heads(gate, DV_A).astype(jnp.float32))
    return o.reshape(B, L, D_A).astype(h.dtype) @ w_out, S


def rope_partial(x, pos):
    inv_freq = ROPE_THETA ** (-jnp.arange(0, ROT_DIM, 2, dtype=jnp.float32) / ROT_DIM)
    ang = pos.astype(jnp.float32)[:, None] * inv_freq[None, :]
    cos = jnp.cos(ang)[None, :, None, None, :]
    sin = jnp.sin(ang)[None, :, None, None, :]
    xr = x[..., :ROT_DIM].astype(jnp.float32)
    x1, x2 = xr[..., :ROT_DIM // 2], xr[..., ROT_DIM // 2:]
    rot = jnp.concatenate([x1 * cos - x2 * sin, x2 * cos + x1 * sin], axis=-1).astype(x.dtype)
    return jnp.concatenate([rot, x[..., ROT_DIM:]], axis=-1)


def shared_kv(h, norm_kv, w_kv, pos):
    B, L, _ = h.shape
    k, v = jnp.split(rms_norm(h, norm_kv) @ w_kv, 2, axis=-1)
    k = rope_partial(k.reshape(B, L, N_KV_B, 2, DH_B), pos).reshape(B, L, N_KV_B, 2 * DH_B)
    v = v.reshape(B, L, N_KV_B, 2 * DH_B)
    return k, v


def diff_attention(h, k_all, v_all, q_pos, k_pos, w_q, lq1, lk1, lq2, lk2, sub_gain, w_out, lam_init):
    B, L, _ = h.shape
    Lk = k_all.shape[1]
    q = rope_partial((h @ w_q).reshape(B, L, H_B, 2, DH_B), q_pos)
    lam = (jnp.exp(jnp.sum(lq1.astype(jnp.float32) * lk1.astype(jnp.float32)))
           - jnp.exp(jnp.sum(lq2.astype(jnp.float32) * lk2.astype(jnp.float32))) + lam_init)
    k = k_all.reshape(B, Lk, N_KV_B, 2, DH_B)
    v = v_all.astype(jnp.float32)
    k_chunk = k_pos // CHUNK
    QB = min(Q_BLOCK, L)
    nb = L // QB
    q_blocks = q.reshape(B, nb, QB, N_KV_B, G_B, 2, DH_B).transpose(1, 0, 2, 3, 4, 5, 6)
    qc_blocks = (q_pos // CHUNK).reshape(nb, QB)

    def block(args):
        qb, qc = args
        s = jnp.einsum('bqkgmd,bskmd->bkgmqs', qb, k,
                       preferred_element_type=jnp.float32) * DH_B ** -0.5
        mask = k_chunk[None, :] <= qc[:, None]
        p = jax.nn.softmax(jnp.where(mask, s, -jnp.inf), axis=-1)
        a = p[:, :, :, 0] - lam * p[:, :, :, 1]
        return jnp.einsum('bkgqs,bskv->bqkgv', a, v)

    o = lax.map(block, (q_blocks, qc_blocks))
    o = o.transpose(1, 0, 2, 3, 4, 5).reshape(B, L, H_B, 2 * DH_B)
    o = rms_norm(o, sub_gain) * (1.0 - lam_init)
    return o.reshape(B, L, H_B * 2 * DH_B).astype(h.dtype) @ w_out


def setup_inputs(seed: int = 0) -> dict:
    key = jax.random.key(seed)
    ks = iter(jax.random.split(key, 32))
    nrm = lambda shape, scale: jax.random.normal(next(ks), shape, jnp.float32) * scale
    gain = lambda shape: 1.0 + nrm(shape, 0.02)
    return {
        "x_prompt": nrm((BATCH, SEQ, D_MODEL), 1.0),
        "x_sample": nrm((DEC_BATCH, DEC_SEQ, D_MODEL), 1.0),
        "state_hgrn": nrm((N_A_LAYERS, DEC_BATCH, H_A, DK_A, DV_A), 0.5),
        "cache_k": nrm((DEC_BATCH, PAST_LEN, N_KV_B, 2 * DH_B), 1.0),
        "cache_v": nrm((DEC_BATCH, PAST_LEN, N_KV_B, 2 * DH_B), 1.0),
        "norm_mix_pre": gain((DEPTH, D_MODEL)),
        "norm_mix_post": gain((DEPTH, D_MODEL)),
        "norm_mlp_pre": gain((DEPTH, D_MODEL)),
        "norm_mlp_post": gain((DEPTH, D_MODEL)),
        "w_up": nrm((DEPTH, D_MODEL, D_FF), D_MODEL ** -0.5),
        "w_down": nrm((DEPTH, D_FF, D_MODEL), D_FF ** -0.5),
        "w_in_a": nrm((N_A_LAYERS, D_MODEL, 4 * D_A), D_MODEL ** -0.5),
        "lb_logits": nrm((DEPTH, D_A), 0.5),
        "gnorm_a": gain((N_A_LAYERS, DV_A)),
        "w_out_a": nrm((N_A_LAYERS, D_A, D_MODEL), D_A ** -0.5),
        "norm_kv": gain((D_MODEL,)),
        "w_kv": nrm((D_MODEL, 2 * N_KV_B * 2 * DH_B), D_MODEL ** -0.5),
        "w_q_b": nrm((N_B_LAYERS, D_MODEL, H_B * 2 * DH_B), D_MODEL ** -0.5),
        "lam_q1": nrm((N_B_LAYERS, DH_B), 0.1),
        "lam_k1": nrm((N_B_LAYERS, DH_B), 0.1),
        "lam_q2": nrm((N_B_LAYERS, DH_B), 0.1),
        "lam_k2": nrm((N_B_LAYERS, DH_B), 0.1),
        "subln_b": gain((N_B_LAYERS, 2 * DH_B)),
        "w_out_b": nrm((N_B_LAYERS, H_B * 2 * DH_B, D_MODEL), (H_B * 2 * DH_B) ** -0.5),
    }


def reference(x_prompt, x_sample, state_hgrn, cache_k, cache_v,
              norm_mix_pre, norm_mix_post, norm_mlp_pre, norm_mlp_post, w_up, w_down,
              w_in_a, lb_logits, gnorm_a, w_out_a, norm_kv, w_kv,
              w_q_b, lam_q1, lam_k1, lam_q2, lam_k2, subln_b, w_out_b):
    lb_all = jnp.cumsum(jax.nn.softmax(lb_logits.astype(jnp.float32), axis=0), axis=0)

    def trunk(x, S0, past_k, past_v):
        B, L, _ = x.shape
        pos0 = 0 if past_k is None else past_k.shape[1]
        pos = pos0 + jnp.arange(L, dtype=jnp.int32)
        h = x
        states = []
        k_new = v_new = k_all = v_all = k_pos = None
        for l in range(DEPTH):
            u = rms_norm(h, norm_mix_pre[l])
            if l < N_A_LAYERS:
                mix, S = hgrn2_mixer(u, S0[l], w_in_a[l], lb_all[l], gnorm_a[l], w_out_a[l])
                states.append(S)
            else:
                j = l - N_A_LAYERS
                if j == 0:
                    k_new, v_new = shared_kv(h, norm_kv, w_kv, pos)
                    if past_k is None:
                        k_all, v_all = k_new, v_new
                    else:
                        k_all = jnp.concatenate([past_k.astype(k_new.dtype), k_new], axis=1)
                        v_all = jnp.concatenate([past_v.astype(v_new.dtype), v_new], axis=1)
                    k_pos = jnp.arange(k_all.shape[1], dtype=jnp.int32)
                lam_init = 0.8 - 0.6 * math.exp(-LAMBDA_INIT_SCALE * l)
                mix = diff_attention(u, k_all, v_all, pos, k_pos, w_q_b[j], lam_q1[j], lam_k1[j],
                                     lam_q2[j], lam_k2[j], subln_b[j], w_out_b[j], lam_init)
            h = h + rms_norm(mix, norm_mix_post[l])
            h = h + rms_norm(squared_relu_mlp(rms_norm(h, norm_mlp_pre[l]), w_up[l], w_down[l]),
                             norm_mlp_post[l])
        return h, jnp.stack(states), k_new, v_new

    S0_prompt = jnp.zeros((N_A_LAYERS, x_prompt.shape[0], H_A, DK_A, DV_A), jnp.float32)
    y_prompt, state_hgrn_prompt, k_prompt, v_prompt = trunk(x_prompt, S0_prompt, None, None)
    y_sample, state_hgrn_sample, k_sample, v_sample = trunk(x_sample, state_hgrn, cache_k, cache_v)
    return (y_prompt, y_sample, state_hgrn_prompt, k_prompt, v_prompt,
            state_hgrn_sample, k_sample, v_sample)
```

```cpp
#include <hip/hip_runtime.h>
#include <hip/hip_cooperative_groups.h>
#include <cstdio>
#include <cstdint>
namespace cg = cooperative_groups;

namespace pg8 {
#define PG8_LAS __attribute__((address_space(3)))
typedef unsigned short bf16_t;
typedef short bf16x8 __attribute__((ext_vector_type(8)));
typedef float f32x4 __attribute__((ext_vector_type(4)));
typedef unsigned u32x4 __attribute__((ext_vector_type(4)));
constexpr int BM = 256, BK = 64, HALF = 128, HTB = HALF * BK * 2  , STAGE_BYTES = 8 * HTB, NXCD = 8, WGM = 8;

__host__ __device__ __forceinline__ int lds_byte(int r, int c) { const int st = (r >> 4) * 2 + (c >> 5), rr = r & 15, cc = c & 31, ob = rr * 64 + cc * 2; return st * 1024 + (ob ^ (((ob >> 9) & 1) << 5)); }
__host__ __device__ __forceinline__ void stage_rc(int b, int& R, int& C) { const int st = b / 1024, sb = b % 1024, swz = sb ^ (((sb >> 9) & 1) << 5); R = (st >> 1) * 16 + swz / 64; C = (st & 1) * 32 + (swz % 64) / 2; }
__host__ __device__ __forceinline__ int perm32(int rho) { const int n = rho >> 4, i = rho & 15; return 8 * (i >> 2) + 4 * n + (i & 3); }

struct Unit { int pm, pn, ko; };
struct Gemm { const bf16_t* A; const bf16_t* Bt; int M, N, K, ld; };

struct StaticOrder {
    int nM, nN, nwg, G, c;
    __host__ __device__ void init(int M, int N, int G_, int c_) { nM = M / BM; nN = N / BM; nwg = nM * nN; G = G_; c = c_; }
    __host__ __device__ bool next(int i, Unit& u) const {
        const long L = (long)i * G + c; if (L >= nwg) return false;
        int wgid = (int)L; { const int q = nwg / NXCD, r = nwg % NXCD, xcd = wgid % NXCD, off = wgid / NXCD; wgid = (xcd < r ? xcd * (q + 1) : r * (q + 1) + (xcd - r) * q) + off; }
        const int nig = WGM * nN, gid = wgid / nig, fm = gid * WGM, gsz = (nM - fm) < WGM ? (nM - fm) : WGM;
        u.pm = fm + ((wgid % nig) % gsz); u.pn = (wgid % nig) / gsz; u.ko = 0; return true;
    }
    __device__ __forceinline__ void a_ready(const Unit&) const {}
    __device__ __forceinline__ void done(const Unit&) const {}
};

__device__ __forceinline__ unsigned cvt_pk_bf16(float lo, float hi) { unsigned r; asm volatile("v_cvt_pk_bf16_f32 %0, %1, %2" : "=v"(r) : "v"(lo), "v"(hi)); return r; }
template <class Epi, class Sched, bool ALIGN_EPI = false, bool SP2 = false>
__device__ __forceinline__ void gemm_phase(PG8_LAS unsigned char* lds, const Gemm g, const Sched& S, const Epi& E) {
    int tid = threadIdx.x; asm volatile("" : "+v"(tid));
    const int wid = __builtin_amdgcn_readfirstlane(tid >> 6), lane = tid & 63, wr = wid >> 2, wc = wid & 3, fr = lane & 15, fq = lane >> 4;
    const int K = g.K, nt = K / BK;
    unsigned voffA[2], voffB[2];
#pragma unroll
    for (int i = 0; i < 2; ++i) { int R, C; stage_rc(tid * 16 + i * 8192, R, C); const int Rb = Epi::PERM ? ((R & ~31) + perm32(R & 31)) : R;
        voffA[i] = (unsigned)(R * g.ld + C) * 2u; voffB[i] = (unsigned)(Rb * g.ld + C) * 2u; }
    const size_t kstep = (size_t)(BK * 2);
    const size_t hstep = (size_t)HALF * g.ld * 2;
    const size_t tstep = 2 * hstep;
    const unsigned ldsw = (unsigned)wid * 1024u;
    const int aoff = lds_byte(wr * 64 + fr, fq * 8), boff = lds_byte(wc * 32 + fr, fq * 8);
#define PG8_SA(b, h) (((b) * 2 + (h)) * HTB)
#define PG8_SB(b, h) ((4 + (b) * 2 + (h)) * HTB)
#define PG8_STAGE(bufoff, gbase, voff) do { _Pragma("unroll") for (int _i = 0; _i < 2; ++_i) \
        __builtin_amdgcn_global_load_lds((const unsigned*)((const char*)(gbase) + (voff)[_i]), (PG8_LAS unsigned*)(lds + (bufoff) + ldsw + _i * 8192), 16, 0, 0); } while (0)
#define PG8_LDA(dst, b, h) do { _Pragma("unroll") for (int m = 0; m < 4; ++m) _Pragma("unroll") for (int k = 0; k < 2; ++k) dst[m][k] = *(const PG8_LAS bf16x8*)(lds + PG8_SA(b, h) + aoff + m * 2048 + k * 1024); } while (0)
#define PG8_LDB(dst, b, h) do { _Pragma("unroll") for (int n = 0; n < 2; ++n) _Pragma("unroll") for (int k = 0; k < 2; ++k) dst[n][k] = *(const PG8_LAS bf16x8*)(lds + PG8_SB(b, h) + boff + n * 2048 + k * 1024); } while (0)
#define PG8_MMA(ai, bj, At, Bt) do { __builtin_amdgcn_s_setprio(1); _Pragma("unroll") for (int m = 0; m < 4; ++m) _Pragma("unroll") for (int n = 0; n < 2; ++n) _Pragma("unroll") for (int k = 0; k < 2; ++k) \
        acc[ai][bj][m][n] = __builtin_amdgcn_mfma_f32_16x16x32_bf16(Bt[n][k], At[m][k], acc[ai][bj][m][n], 0, 0, 0); __builtin_amdgcn_s_setprio(0); } while (0)
#define PG8_WAIT_V(n) asm volatile("s_waitcnt vmcnt(" #n ")" ::: "memory")
#define PG8_WAIT_L(n) asm volatile("s_waitcnt lgkmcnt(" #n ")" ::: "memory")
#define PG8_BAR __builtin_amdgcn_s_barrier()
#define PG8_SCHED __builtin_amdgcn_sched_barrier(0)
    Unit cur, nxt; int ui = 0;
    if (!S.next(0, cur)) return;
    f32x4 acc[2][2][4][2];
#pragma unroll
    for (int a = 0; a < 2; ++a)
#pragma unroll
        for (int b = 0; b < 2; ++b)
#pragma unroll
            for (int m = 0; m < 4; ++m)
#pragma unroll
                for (int n = 0; n < 2; ++n) acc[a][b][m][n] = (f32x4){0.f, 0.f, 0.f, 0.f};
    bf16x8 At[4][2], B0[2][2], B1[2][2];
    const char* cA = (const char*)g.A + (size_t)cur.pm * tstep + (size_t)cur.ko * 2; const char* cB = (const char*)g.Bt + (size_t)cur.pn * tstep + (size_t)cur.ko * 2;
    S.a_ready(cur);
    if constexpr (SP2) {
        PG8_STAGE(PG8_SB(0, 0), cB, voffB); PG8_STAGE(PG8_SB(0, 1), cB + hstep, voffB); PG8_STAGE(PG8_SA(0, 0), cA, voffA); PG8_STAGE(PG8_SA(0, 1), cA + hstep, voffA);
        if (wr == 1) PG8_BAR;
        PG8_WAIT_V(2); PG8_BAR;
        PG8_STAGE(PG8_SB(1, 0), cB + kstep, voffB); PG8_STAGE(PG8_SA(1, 0), cA + kstep, voffA); PG8_STAGE(PG8_SB(1, 1), cB + hstep + kstep, voffB);
        PG8_WAIT_V(6); PG8_BAR;
    } else {
        PG8_STAGE(PG8_SB(0, 0), cB, voffB); PG8_STAGE(PG8_SA(0, 0), cA, voffA); PG8_STAGE(PG8_SB(0, 1), cB + hstep, voffB); PG8_STAGE(PG8_SA(0, 1), cA + hstep, voffA);
        if (wr == 1) PG8_BAR;
        PG8_WAIT_V(4); PG8_BAR;
        PG8_STAGE(PG8_SB(1, 0), cB + kstep, voffB); PG8_STAGE(PG8_SA(1, 0), cA + kstep, voffA); PG8_STAGE(PG8_SB(1, 1), cB + hstep + kstep, voffB);
        PG8_WAIT_V(6); PG8_BAR;
    }
    for (;;) {
        const bool has_next = S.next(ui + 1, nxt);
        const char* nA = has_next ? (const char*)g.A + (size_t)nxt.pm * tstep + (size_t)nxt.ko * 2 : cA; const char* nB = has_next ? (const char*)g.Bt + (size_t)nxt.pn * tstep + (size_t)nxt.ko * 2 : cB;
        for (int t = 0; t < nt; t += 2) {
            const bool last = (t == nt - 2);
            const char* a1 = cA + (size_t)(t + 1) * kstep;
            const char* a2 = last ? nA : cA + (size_t)(t + 2) * kstep; const char* b2 = last ? nB : cB + (size_t)(t + 2) * kstep;
            const char* a3 = a2 + kstep; const char* b3 = b2 + kstep;
            if (last && has_next) S.a_ready(nxt);
            if constexpr (SP2) {
            PG8_LDB(B0, 0, 0); PG8_LDB(B1, 0, 1); PG8_SCHED; PG8_LDA(At, 0, 0); PG8_STAGE(PG8_SA(1, 1), a1 + hstep, voffA);
            PG8_WAIT_V(8); PG8_WAIT_L(0); PG8_BAR; PG8_MMA(0, 0, At, B0); PG8_MMA(0, 1, At, B1); PG8_BAR; PG8_SCHED;
            PG8_LDA(At, 0, 1); PG8_STAGE(PG8_SB(0, 0), b2, voffB); PG8_STAGE(PG8_SB(0, 1), b2 + hstep, voffB); PG8_STAGE(PG8_SA(0, 0), a2, voffA);
            PG8_WAIT_V(8); PG8_WAIT_L(0); PG8_BAR; PG8_MMA(1, 0, At, B0); PG8_MMA(1, 1, At, B1); PG8_BAR; PG8_SCHED;
            PG8_LDB(B0, 1, 0); PG8_LDB(B1, 1, 1); PG8_SCHED; PG8_LDA(At, 1, 0); PG8_STAGE(PG8_SA(0, 1), a2 + hstep, voffA);
            PG8_WAIT_V(8); PG8_WAIT_L(0); PG8_BAR; PG8_MMA(0, 0, At, B0); PG8_MMA(0, 1, At, B1); PG8_BAR; PG8_SCHED;
            PG8_LDA(At, 1, 1); PG8_STAGE(PG8_SB(1, 0), b3, voffB); PG8_STAGE(PG8_SB(1, 1), b3 + hstep, voffB); PG8_STAGE(PG8_SA(1, 0), a3, voffA);
            PG8_WAIT_V(8); PG8_WAIT_L(0); PG8_BAR; PG8_MMA(1, 0, At, B0); PG8_MMA(1, 1, At, B1); PG8_BAR; PG8_SCHED;
            } else {
            PG8_LDB(B0, 0, 0); PG8_SCHED; PG8_LDA(At, 0, 0); PG8_STAGE(PG8_SA(1, 1), a1 + hstep, voffA);
            PG8_WAIT_L(8); PG8_BAR; PG8_WAIT_L(0); PG8_MMA(0, 0, At, B0); PG8_BAR; PG8_SCHED;
            PG8_LDB(B1, 0, 1); PG8_STAGE(PG8_SB(0, 0), b2, voffB);
            PG8_BAR; PG8_WAIT_L(0); PG8_MMA(0, 1, At, B1); PG8_BAR;
            PG8_LDA(At, 0, 1); PG8_STAGE(PG8_SA(0, 0), a2, voffA);
            PG8_BAR; PG8_WAIT_L(0); PG8_MMA(1, 0, At, B0); PG8_BAR; PG8_SCHED;
            PG8_STAGE(PG8_SB(0, 1), b2 + hstep, voffB);
            PG8_WAIT_V(6); PG8_BAR; PG8_MMA(1, 1, At, B1); PG8_BAR;
            PG8_LDB(B0, 1, 0); PG8_SCHED; PG8_LDA(At, 1, 0); PG8_STAGE(PG8_SA(0, 1), a2 + hstep, voffA);
            PG8_WAIT_L(8); PG8_BAR; PG8_WAIT_L(0); PG8_MMA(0, 0, At, B0); PG8_BAR; PG8_SCHED;
            PG8_LDB(B1, 1, 1); PG8_STAGE(PG8_SB(1, 0), b3, voffB);
            PG8_BAR; PG8_WAIT_L(0); PG8_MMA(0, 1, At, B1); PG8_BAR;
            PG8_LDA(At, 1, 1); PG8_STAGE(PG8_SA(1, 0), a3, voffA);
            PG8_BAR; PG8_WAIT_L(0); PG8_MMA(1, 0, At, B0); PG8_BAR; PG8_SCHED;
            PG8_STAGE(PG8_SB(1, 1), b3 + hstep, voffB);
            PG8_WAIT_V(6); PG8_BAR; PG8_MMA(1, 1, At, B1); PG8_BAR;
            }
        }
        if constexpr (ALIGN_EPI) { if (wr == 0) PG8_BAR; }
        if constexpr (!Epi::AFTER_DRAIN) { E(acc, cur, wr, wc, fr, fq); S.done(cur); }
        if (!has_next) break;
#pragma unroll
        for (int a = 0; a < 2; ++a)
#pragma unroll
            for (int b = 0; b < 2; ++b)
#pragma unroll
                for (int m = 0; m < 4; ++m)
#pragma unroll
                    for (int n = 0; n < 2; ++n) acc[a][b][m][n] = (f32x4){0.f, 0.f, 0.f, 0.f};
        cur = nxt; cA = nA; cB = nB; ++ui;
        if constexpr (ALIGN_EPI) { if (wr == 1) PG8_BAR; }
    }
    PG8_WAIT_V(0);
    if constexpr (!ALIGN_EPI) { if (wr == 0) PG8_BAR; }
    PG8_BAR;
    if constexpr (Epi::AFTER_DRAIN) { E.fused(acc, cur, wr, wc, fr, fq, lds, wid, lane); S.done(cur); }
#undef PG8_SA
#undef PG8_SB
#undef PG8_STAGE
#undef PG8_LDA
#undef PG8_LDB
#undef PG8_MMA
#undef PG8_WAIT_V
#undef PG8_WAIT_L
#undef PG8_BAR
#undef PG8_SCHED
}
}

namespace mk {
using pg8::bf16_t; using pg8::f32x4; using pg8::u32x4; using pg8::bf16x8; using pg8::Unit;
typedef float f32x16 __attribute__((ext_vector_type(16)));
typedef float f32x2 __attribute__((ext_vector_type(2)));
typedef unsigned u32x2 __attribute__((ext_vector_type(2)));
typedef short s16x4 __attribute__((ext_vector_type(4)));
#define DI __device__ __forceinline__
#define LAS __attribute__((address_space(3)))
typedef LAS unsigned char* ldsp;

constexpr int M = 34816, MP = 32768, D = 1024, FF = 4096, NCHUNK = 544, NCHP = 512;
constexpr float EPS = 1e-6f;
constexpr float LAM_INIT = 0.35550906759096934f;
constexpr float QSCALE = 0.18033688011112042f;
constexpr float QA_SCALE = 0.08838834764831845f;
constexpr size_t O_Y = 0, O_SP = 35651584, O_KP = 35913728, O_VP = 52690944, O_SS = 69468160, O_KS = 73662464, O_VS = 74711040;
constexpr size_t MiB = 1u << 20;
constexpr size_t WS_CTL = 0, WS_WIN = 2 * MiB, WS_WOA = 10 * MiB, WS_WUP0 = 12 * MiB, WS_WDN0 = 20 * MiB, WS_WKVQ = 28 * MiB, WS_WOB = 32 * MiB, WS_WUP1 = 34 * MiB, WS_WDN1 = 42 * MiB;
constexpr size_t WS_COS = 50 * MiB, WS_SIN = 50 * MiB + 512 * 1024, WS_RINV = 51 * MiB, WS_DEC = 52 * MiB;
constexpr size_t WS_XB = 56 * MiB, WS_QB = 124 * MiB, WS_VB = 192 * MiB, WS_KB = 192 * MiB, WS_VB2 = 226 * MiB, WS_GATE = 260 * MiB, WS_MIXB = 260 * MiB;
constexpr size_t WS_G = 328 * MiB, WS_UT = 464 * MiB, WS_HB = 328 * MiB, WS_OB = 600 * MiB, WS_END = 720 * MiB;
constexpr int LDS_BYTES = 147456;

struct Params { const float* in[24]; float* out; unsigned char* ws; unsigned mask; unsigned pad; };
enum { I_XP = 0, I_XS, I_STATE, I_CK, I_CV, I_NMIXPRE, I_NMIXPOST, I_NMLPPRE, I_NMLPPOST, I_WUP, I_WDOWN, I_WIN, I_LB, I_GNORM, I_WOA, I_NKV, I_WKV, I_WQ, I_LQ1, I_LK1, I_LQ2, I_LK2, I_SUBLN, I_WOB };

DI unsigned pk2(float lo, float hi) { typedef __bf16 bf2 __attribute__((ext_vector_type(2))); f32x2 v = {lo, hi}; bf2 b = __builtin_convertvector(v, bf2); return __builtin_bit_cast(unsigned, b); }
DI float bflo(unsigned w) { return __uint_as_float(w << 16); }
DI float bfhi(unsigned w) { return __uint_as_float(w & 0xffff0000u); }
DI float bf2f(unsigned short u) { return __uint_as_float((unsigned)u << 16); }
DI unsigned short f2bf(float f) { return (unsigned short)(pk2(f, 0.f) & 0xffffu); }
DI float wave_sum(float v) {
#pragma unroll
    for (int o = 1; o < 64; o <<= 1) v += __shfl_xor(v, o);
    return v;
}
DI float fsigmoid(float x) { return __builtin_amdgcn_rcpf(1.f + __expf(-x)); }
DI float fsilu(float x) { return x * fsigmoid(x); }
DI int crow(int r, int hi) { return (r & 3) + 8 * (r >> 2) + 4 * hi; }
#define LDS_WAIT() asm volatile("s_waitcnt lgkmcnt(0)" ::: "memory")
DI f32x16 mfma32(bf16x8 a, bf16x8 b, f32x16 c) { return __builtin_amdgcn_mfma_f32_32x32x16_bf16(a, b, c, 0, 0, 0); }
DI f32x16 zero16() { f32x16 z;
#pragma unroll
    for (int i = 0; i < 16; ++i) z[i] = 0.f; return z; }
DI bf16x8 pack8(const f32x16& x, int s) {
    u32x4 p; p.x = pk2(x[8 * s + 0], x[8 * s + 1]); p.y = pk2(x[8 * s + 2], x[8 * s + 3]); p.z = pk2(x[8 * s + 4], x[8 * s + 5]); p.w = pk2(x[8 * s + 6], x[8 * s + 7]);
    return __builtin_bit_cast(bf16x8, p);
}
typedef short v4i16_t __attribute__((ext_vector_type(4)));
DI s16x4 vtr(LAS const unsigned char* p) { return __builtin_bit_cast(s16x4, __builtin_amdgcn_ds_read_tr16_b64_v4i16((LAS v4i16_t*)p)); }

struct EpiIn {
    static constexpr bool PERM = true, AFTER_DRAIN = false;
    unsigned char* ws; const float* lbl;
    DI void operator()(const f32x4 (&acc)[2][2][4][2], const Unit& u, int wr, int wc, int fr, int fq) const {
        const float* rinv = (const float*)(ws + WS_RINV); bf16_t* QB = (bf16_t*)(ws + WS_QB); bf16_t* G = (bf16_t*)(ws + WS_G); bf16_t* VB = (bf16_t*)(ws + WS_VB); bf16_t* GATE = (bf16_t*)(ws + WS_GATE);
        const int part = u.pn >> 2; const int cbase = (u.pn & 3) * 256 + wc * 32 + 8 * fq;
        float lb[2][8];
        if (part == 1) {
#pragma unroll
            for (int bj = 0; bj < 2; ++bj)
#pragma unroll
                for (int i = 0; i < 8; ++i) { const int c = cbase + bj * 128 + i; lb[bj][i] = fsigmoid(lbl[c] - lbl[1024 + c]); }
        }
#pragma unroll
        for (int ai = 0; ai < 2; ++ai)
#pragma unroll
            for (int m = 0; m < 4; ++m) {
                const int row = u.pm * 256 + ai * 128 + wr * 64 + m * 16 + fr; const float rs = rinv[row];
#pragma unroll
                for (int bj = 0; bj < 2; ++bj) {
                    const int c = cbase + bj * 128; float v[8];
#pragma unroll
                    for (int i = 0; i < 4; ++i) { v[i] = acc[ai][bj][m][0][i] * rs; v[4 + i] = acc[ai][bj][m][1][i] * rs; }
                    if (part == 1) {
                        f32x4 g0, g1;
#pragma unroll
                        for (int i = 0; i < 8; ++i) { const float f = lb[bj][i] + (1.f - lb[bj][i]) * fsigmoid(v[i]); const float g = __logf(f); if (i < 4) g0[i] = g; else g1[i - 4] = g; }
                        u32x4 w; w.x = pk2(g0[0], g0[1]); w.y = pk2(g0[2], g0[3]); w.z = pk2(g1[0], g1[1]); w.w = pk2(g1[2], g1[3]); *(u32x4*)(G + (size_t)row * 1024 + c) = w;
                    } else {
                        bf16_t* o = (part == 0 ? QB : (part == 2 ? VB : GATE)) + (size_t)row * 1024 + c;
                        if (part == 0) {
#pragma unroll
                            for (int i = 0; i < 8; ++i) v[i] = fsilu(v[i]) * QA_SCALE;
                        } else if (part == 3) {
#pragma unroll
                            for (int i = 0; i < 8; ++i) v[i] = fsilu(v[i]);
                        }
                        u32x4 w; w.x = pk2(v[0], v[1]); w.y = pk2(v[2], v[3]); w.z = pk2(v[4], v[5]); w.w = pk2(v[6], v[7]); *(u32x4*)o = w;
                    }
                }
            }
    }
};
struct EpiUp {
    static constexpr bool PERM = true, AFTER_DRAIN = false;
    unsigned char* ws;
    DI void operator()(const f32x4 (&acc)[2][2][4][2], const Unit& u, int wr, int wc, int fr, int fq) const {
        const float* rinv = (const float*)(ws + WS_RINV); bf16_t* HB = (bf16_t*)(ws + WS_HB);
        const int cbase = u.pn * 256 + wc * 32 + 8 * fq;
#pragma unroll
        for (int ai = 0; ai < 2; ++ai)
#pragma unroll
            for (int m = 0; m < 4; ++m) {
                const int row = u.pm * 256 + ai * 128 + wr * 64 + m * 16 + fr; const float rs = rinv[row];
#pragma unroll
                for (int bj = 0; bj < 2; ++bj) {
                    float v[8];
#pragma unroll
                    for (int i = 0; i < 4; ++i) { v[i] = acc[ai][bj][m][0][i] * rs; v[4 + i] = acc[ai][bj][m][1][i] * rs; }
#pragma unroll
                    for (int i = 0; i < 8; ++i) { const float t = fmaxf(v[i], 0.f); v[i] = t * t; }
                    u32x4 w; w.x = pk2(v[0], v[1]); w.y = pk2(v[2], v[3]); w.z = pk2(v[4], v[5]); w.w = pk2(v[6], v[7]);
                    *(u32x4*)(HB + (size_t)row * FF + cbase + bj * 128) = w;
                }
            }
    }
};
struct EpiMix {
    static constexpr bool PERM = true, AFTER_DRAIN = false;
    unsigned char* ws;
    DI void operator()(const f32x4 (&acc)[2][2][4][2], const Unit& u, int wr, int wc, int fr, int fq) const {
        bf16_t* MIXB = (bf16_t*)(ws + WS_MIXB);
        const int cbase = u.pn * 256 + wc * 32 + 8 * fq;
#pragma unroll
        for (int ai = 0; ai < 2; ++ai)
#pragma unroll
            for (int m = 0; m < 4; ++m) {
                const int row = u.pm * 256 + ai * 128 + wr * 64 + m * 16 + fr;
#pragma unroll
                for (int bj = 0; bj < 2; ++bj) {
                    const f32x4 a = acc[ai][bj][m][0], b = acc[ai][bj][m][1];
                    u32x4 w; w.x = pk2(a[0], a[1]); w.y = pk2(a[2], a[3]); w.z = pk2(b[0], b[1]); w.w = pk2(b[2], b[3]);
                    *(u32x4*)(MIXB + (size_t)row * 1024 + cbase + bj * 128) = w;
                }
            }
    }
};
struct EpiKvq {
    static constexpr bool PERM = true, AFTER_DRAIN = false;
    unsigned char* ws; float* out;
    DI void operator()(const f32x4 (&acc)[2][2][4][2], const Unit& u, int wr, int wc, int fr, int fq) const {
        const float* rinv = (const float*)(ws + WS_RINV); bf16_t* KB = (bf16_t*)(ws + WS_KB); bf16_t* VB2 = (bf16_t*)(ws + WS_VB2); bf16_t* QB2 = (bf16_t*)(ws + WS_QB); const float* COS = (const float*)(ws + WS_COS); const float* SIN = (const float*)(ws + WS_SIN);
        const int sec = u.pn < 2 ? 0 : (u.pn < 4 ? 1 : 2);
        const int cbase = u.pn * 256 + wc * 32 + 8 * fq;
        const bool rot = (sec != 1) && ((wc & 1) == 0);
#pragma unroll
        for (int ai = 0; ai < 2; ++ai)
#pragma unroll
            for (int m = 0; m < 4; ++m) {
                const int row = u.pm * 256 + ai * 128 + wr * 64 + m * 16 + fr; const float rs = rinv[row];
                const int pos = row < MP ? (row & 16383) : 4096 + ((row - MP) & 63);
                f32x4 c0, c1, s0, s1;
                if (rot) { c0 = *(const f32x4*)(COS + pos * 8); c1 = *(const f32x4*)(COS + pos * 8 + 4); s0 = *(const f32x4*)(SIN + pos * 8); s1 = *(const f32x4*)(SIN + pos * 8 + 4); }
#pragma unroll
                for (int bj = 0; bj < 2; ++bj) {
                    const int c = cbase + bj * 128; float v[8];
#pragma unroll
                    for (int i = 0; i < 4; ++i) { v[i] = acc[ai][bj][m][0][i] * rs; v[4 + i] = acc[ai][bj][m][1][i] * rs; }
                    if (rot) {
#pragma unroll
                        for (int i = 0; i < 8; ++i) {
                            const float pv = __shfl_xor(v[i], 16);
                            const float cs = i < 4 ? c0[i & 3] : c1[i & 3], sn = i < 4 ? s0[i & 3] : s1[i & 3];
                            const float r0 = v[i] * cs - pv * sn, r1 = v[i] * cs + pv * sn;
                            v[i] = fq == 0 ? r0 : (fq == 1 ? r1 : v[i]);
                        }
                    }
                    if (sec == 2) {
#pragma unroll
                        for (int i = 0; i < 8; ++i) v[i] *= QSCALE;
                        u32x4 w; w.x = pk2(v[0], v[1]); w.y = pk2(v[2], v[3]); w.z = pk2(v[4], v[5]); w.w = pk2(v[6], v[7]);
                        *(u32x4*)(QB2 + (size_t)row * 1024 + (c - 1024)) = w;
                    } else {
                        const int cc = sec == 0 ? c : c - 512;
                        float* o = out + (row < MP ? (sec == 0 ? O_KP : O_VP) + (size_t)row * 512 : (sec == 0 ? O_KS : O_VS) + (size_t)(row - MP) * 512) + cc;
                        *(f32x4*)o = (f32x4){v[0], v[1], v[2], v[3]}; *(f32x4*)(o + 4) = (f32x4){v[4], v[5], v[6], v[7]};
                        u32x4 w; w.x = pk2(v[0], v[1]); w.y = pk2(v[2], v[3]); w.z = pk2(v[4], v[5]); w.w = pk2(v[6], v[7]);
                        *(u32x4*)((sec == 0 ? KB : VB2) + (size_t)row * 512 + cc) = w;
                    }
                }
            }
    }
};

DI void transpose_item(const float* W, int K, int N, bf16_t* WT, int row_off, const float* gain, LAS float* scr, int item, int lane) {
    const int nblk = N / 32, kb = item / nblk, nb = item % nblk, k0 = 64 * kb, n0 = 32 * nb;
#pragma unroll 8
    for (int i = 0; i < 32; ++i) { const int kk = 2 * i + (lane >> 5); float w = W[(size_t)(k0 + kk) * N + n0 + (lane & 31)]; if (gain) w *= gain[k0 + kk]; scr[kk * 33 + (lane & 31)] = w; }
    LDS_WAIT(); asm volatile("" ::: "memory");
    const int c = lane & 7;
#pragma unroll
    for (int j = 0; j < 4; ++j) { const int n = (lane >> 3) + 8 * j; const LAS float* s = scr + (8 * c) * 33 + n;
        u32x4 o; o.x = pk2(s[0 * 33], s[1 * 33]); o.y = pk2(s[2 * 33], s[3 * 33]); o.z = pk2(s[4 * 33], s[5 * 33]); o.w = pk2(s[6 * 33], s[7 * 33]);
        *(u32x4*)(WT + (size_t)(row_off + n0 + n) * K + k0 + 8 * c) = o; }
    LDS_WAIT(); asm volatile("" ::: "memory");
}
DI void phase0(const Params& p, ldsp lds, int tid, int lane, int wave, unsigned full) {
    unsigned char* ws = p.ws;
    if (blockIdx.x == 0) { unsigned* ctl = (unsigned*)(ws + WS_CTL); for (int i = tid; i < 8192; i += 512) ctl[i] = 0u; }
    if (!full) return;
    const int gw = blockIdx.x * 8 + wave, NGW = gridDim.x * 8;
    LAS float* scr = (LAS float*)(lds + wave * 16384);
    constexpr int I_A = 16 * 128, I_B = 16 * 32, I_C = 64 * 32;
    constexpr int NITEMS = 4 * I_A + 4 * I_B + 2 * I_C - I_A;
    static_assert(NITEMS == 3 * I_A + 4 * I_B + 2 * I_C, "items");
    for (int it = gw; it < NITEMS; it += NGW) {
        int r = it;
        if (r < I_A) { transpose_item(p.in[I_WIN], 1024, 4096, (bf16_t*)(ws + WS_WIN), 0, p.in[I_NMIXPRE], scr, r, lane); continue; } r -= I_A;
        if (r < I_A) { transpose_item(p.in[I_WUP], 1024, 4096, (bf16_t*)(ws + WS_WUP0), 0, p.in[I_NMLPPRE], scr, r, lane); continue; } r -= I_A;
        if (r < I_A) { transpose_item(p.in[I_WUP] + (size_t)1024 * 4096, 1024, 4096, (bf16_t*)(ws + WS_WUP1), 0, p.in[I_NMLPPRE] + 1024, scr, r, lane); continue; } r -= I_A;
        if (r < I_C) { transpose_item(p.in[I_WDOWN], 4096, 1024, (bf16_t*)(ws + WS_WDN0), 0, nullptr, scr, r, lane); continue; } r -= I_C;
        if (r < I_C) { transpose_item(p.in[I_WDOWN] + (size_t)4096 * 1024, 4096, 1024, (bf16_t*)(ws + WS_WDN1), 0, nullptr, scr, r, lane); continue; } r -= I_C;
        if (r < I_B) { transpose_item(p.in[I_WOA], 1024, 1024, (bf16_t*)(ws + WS_WOA), 0, nullptr, scr, r, lane); continue; } r -= I_B;
        if (r < I_B) { transpose_item(p.in[I_WKV], 1024, 1024, (bf16_t*)(ws + WS_WKVQ), 0, p.in[I_NKV], scr, r, lane); continue; } r -= I_B;
        if (r < I_B) { transpose_item(p.in[I_WQ], 1024, 1024, (bf16_t*)(ws + WS_WKVQ), 1024, p.in[I_NMIXPRE] + 1024, scr, r, lane); continue; } r -= I_B;
        transpose_item(p.in[I_WOB], 1024, 1024, (bf16_t*)(ws + WS_WOB), 0, nullptr, scr, r, lane);
    }
    float* RINV = (float*)(ws + WS_RINV); bf16_t* XB = (bf16_t*)(ws + WS_XB);
    for (int m = gw; m < M; m += NGW) {
        const float* xr = m < MP ? p.in[I_XP] + (size_t)m * 1024 : p.in[I_XS] + (size_t)(m - MP) * 1024;
        f32x4 v[4]; float s = 0.f;
#pragma unroll
        for (int j = 0; j < 4; ++j) { v[j] = ((const f32x4*)xr)[lane + 64 * j]; s += (v[j].x * v[j].x + v[j].y * v[j].y) + (v[j].z * v[j].z + v[j].w * v[j].w); }
        s = wave_sum(s);
        if (lane == 0) RINV[m] = rsqrtf(s * (1.f / 1024.f) + EPS);
        u32x2* o = (u32x2*)(XB + (size_t)m * 1024) + lane;
#pragma unroll
        for (int j = 0; j < 4; ++j) { u32x2 w; w.x = pk2(v[j].x, v[j].y); w.y = pk2(v[j].z, v[j].w); o[64 * j] = w; }
    }
    float* COS = (float*)(ws + WS_COS); float* SIN = (float*)(ws + WS_SIN);
    for (int i = blockIdx.x * 512 + tid; i < 16384 * 8; i += gridDim.x * 512) {
        const int pos = i >> 3, d = i & 7;
        const double f = d == 0 ? 1.0 : d == 1 ? 0.19392274474868576 : d == 2 ? 0.03760603093086393 : d == 3 ? 0.007292664737217109 : d == 4 ? 0.001414213562373095 : d == 5 ? 0.0002742481756762073 : d == 6 ? 5.318295896944988e-05 : 1.031338537721246e-05;
        const float invf = (float)f;
        const float angf = (float)pos * invf;
        const double rev = (double)angf * 0.15915494309189535;
        const float fr = (float)(rev - __builtin_floor(rev));
        COS[i] = __builtin_amdgcn_cosf(fr); SIN[i] = __builtin_amdgcn_sinf(fr);
    }
}

template <bool FIRST, bool LAST> DI void thin_phase(const Params& p, const float* gpost, int lane, int wave) {
    unsigned char* ws = p.ws;
    const int gw = blockIdx.x * 8 + wave, NGW = gridDim.x * 8;
    float* RINV = (float*)(ws + WS_RINV); bf16_t* XB = (bf16_t*)(ws + WS_XB); const bf16_t* MIXB = (const bf16_t*)(ws + WS_MIXB); float* Y = p.out + O_Y;
    f32x4 gp[4];
#pragma unroll
    for (int j = 0; j < 4; ++j) gp[j] = ((const f32x4*)gpost)[lane + 64 * j];
    for (int m = gw; m < M; m += NGW) {
        const u32x2* mx = (const u32x2*)(MIXB + (size_t)m * 1024) + lane;
        f32x4 mv[4], hv[4]; float s = 0.f;
        if (FIRST) {
            const float* hr = m < MP ? p.in[I_XP] + (size_t)m * 1024 : p.in[I_XS] + (size_t)(m - MP) * 1024;
#pragma unroll
            for (int j = 0; j < 4; ++j) hv[j] = ((const f32x4*)hr)[lane + 64 * j];
        } else {
            const u32x2* hx = (const u32x2*)(XB + (size_t)m * 1024) + lane;
#pragma unroll
            for (int j = 0; j < 4; ++j) { const u32x2 w = hx[64 * j]; hv[j] = (f32x4){bflo(w.x), bfhi(w.x), bflo(w.y), bfhi(w.y)}; }
        }
        if (m < MP) {
#pragma unroll
            for (int j = 0; j < 4; ++j) { const u32x2 w = mx[64 * j]; mv[j] = (f32x4){bflo(w.x), bfhi(w.x), bflo(w.y), bfhi(w.y)}; }
        } else {
            const f32x4* pp = (const f32x4*)((const float*)(ws + WS_QB) + (size_t)(m - MP) * 1024) + lane;
#pragma unroll
            for (int j = 0; j < 4; ++j) { f32x4 a = pp[64 * j];
#pragma unroll
                for (int ks = 1; ks < 8; ++ks) a = a + pp[(size_t)ks * 2048 * 256 + 64 * j];
                mv[j] = a; }
        }
#pragma unroll
        for (int j = 0; j < 4; ++j) s += (mv[j].x * mv[j].x + mv[j].y * mv[j].y) + (mv[j].z * mv[j].z + mv[j].w * mv[j].w);
        s = wave_sum(s);
        const float r1 = rsqrtf(s * (1.f / 1024.f) + EPS);
#pragma unroll
        for (int j = 0; j < 4; ++j) hv[j] = hv[j] + mv[j] * r1 * gp[j];
        if (LAST) {
#pragma unroll
            for (int j = 0; j < 4; ++j) ((f32x4*)(Y + (size_t)m * 1024))[lane + 64 * j] = hv[j];
        } else {
            u32x2 w[4]; float s2 = 0.f;
#pragma unroll
            for (int j = 0; j < 4; ++j) { w[j].x = pk2(hv[j].x, hv[j].y); w[j].y = pk2(hv[j].z, hv[j].w);
                const float a = bflo(w[j].x), b = bfhi(w[j].x), c = bflo(w[j].y), d = bfhi(w[j].y); s2 += (a * a + b * b) + (c * c + d * d); }
            s2 = wave_sum(s2);
            if (lane == 0) RINV[m] = rsqrtf(s2 * (1.f / 1024.f) + EPS);
            u32x2* o = (u32x2*)(XB + (size_t)m * 1024) + lane;
#pragma unroll
            for (int j = 0; j < 4; ++j) o[64 * j] = w[j];
        }
    }
}

DI void hgrn_a(const Params& p, ldsp lds, int tid, int lane, int wave) {
    unsigned char* ws = p.ws;
    const bf16_t* G = (const bf16_t*)(ws + WS_G); const bf16_t* VB = (const bf16_t*)(ws + WS_VB); bf16_t* UT = (bf16_t*)(ws + WS_UT); float* DEC = (float*)(ws + WS_DEC);
    LAS float* TOT = (LAS float*)(lds + 36864); LAS float* DECL = (LAS float*)(lds + 38912);
    const int d = tid & 127, tq = tid >> 7, r = lane & 31, h = lane >> 5;
    float gv[16]; unsigned short vv[16];
#define HA_LOAD(u_) do { const int cg_ = (u_) >> 3, hh_ = (u_) & 7; const size_t o_ = (size_t)(cg_ * 64 + 16 * tq) * 1024 + hh_ * 128 + d; \
        _Pragma("unroll") for (int i = 0; i < 16; ++i) { gv[i] = bf2f(G[o_ + (size_t)i * 1024]); vv[i] = VB[o_ + (size_t)i * 1024]; } } while (0)
    int unit = blockIdx.x;
    if (unit < NCHUNK * 8) HA_LOAD(unit);
    for (; unit < NCHUNK * 8; unit += gridDim.x) {
        const int cgi = unit >> 3, hh = unit & 7;
        float bl[16], kk[16];
        { float c = 0.f;
#pragma unroll
          for (int i = 0; i < 16; ++i) { kk[i] = 1.f - __expf(gv[i]); c += gv[i]; bl[i] = c; }
          TOT[tq * 128 + d] = c; }
        { u32x4 x0, x1;
          x0.x = vv[0] | ((unsigned)vv[1] << 16); x0.y = vv[2] | ((unsigned)vv[3] << 16); x0.z = vv[4] | ((unsigned)vv[5] << 16); x0.w = vv[6] | ((unsigned)vv[7] << 16);
          x1.x = vv[8] | ((unsigned)vv[9] << 16); x1.y = vv[10] | ((unsigned)vv[11] << 16); x1.z = vv[12] | ((unsigned)vv[13] << 16); x1.w = vv[14] | ((unsigned)vv[15] << 16);
          *(LAS u32x4*)(lds + 18432 + d * 144 + tq * 32) = x0; *(LAS u32x4*)(lds + 18432 + d * 144 + tq * 32 + 16) = x1; }
        if (unit + (int)gridDim.x < NCHUNK * 8) HA_LOAD(unit + (int)gridDim.x);
        __syncthreads();
        float off = 0.f, blast = 0.f;
#pragma unroll
        for (int j = 0; j < 4; ++j) { const float t = TOT[j * 128 + d]; blast += t; if (j < tq) off += t; }
        { u32x4 w0, w1; float e[16];
#pragma unroll
          for (int i = 0; i < 16; ++i) e[i] = kk[i] * __expf(blast - (bl[i] + off));
          w0.x = pk2(e[0], e[1]); w0.y = pk2(e[2], e[3]); w0.z = pk2(e[4], e[5]); w0.w = pk2(e[6], e[7]); w1.x = pk2(e[8], e[9]); w1.y = pk2(e[10], e[11]); w1.z = pk2(e[12], e[13]); w1.w = pk2(e[14], e[15]);
          *(LAS u32x4*)(lds + d * 144 + tq * 32) = w0; *(LAS u32x4*)(lds + d * 144 + tq * 32 + 16) = w1; }
        if (tq == 0) { const float dc = __expf(blast); DECL[d] = dc; DEC[(size_t)(cgi * 8 + hh) * 128 + d] = dc; }
        __syncthreads();
        const int bm = wave >> 1;
#pragma unroll
        for (int q = 0; q < 2; ++q) {
            const int bn = 2 * (wave & 1) + q;
            f32x16 acc = zero16();
#pragma unroll
            for (int ks = 0; ks < 4; ++ks) {
                const bf16x8 a = *(const LAS bf16x8*)(lds + 18432 + (32 * bm + r) * 144 + (16 * ks + 8 * h) * 2);
                const bf16x8 b = *(const LAS bf16x8*)(lds + (32 * bn + r) * 144 + (16 * ks + 8 * h) * 2);
                acc = mfma32(a, b, acc);
            }
            if (cgi < NCHP) {
                bf16_t* up = UT + ((size_t)(cgi * 8 + hh) * 128) * 128 + 32 * bn + r;
#pragma unroll
                for (int reg = 0; reg < 16; ++reg) up[(size_t)(32 * bm + crow(reg, h)) * 128] = f2bf(acc[reg]);
            } else {
                const int bs = cgi - NCHP; const int dk = 32 * bn + r; const float dc = DECL[dk];
                const size_t base = ((size_t)(bs * 8 + hh) * 128 + dk) * 128;
#pragma unroll
                for (int g4 = 0; g4 < 4; ++g4) { const int dv0 = 32 * bm + 8 * g4 + 4 * h;
                    const f32x4 s0 = *(const f32x4*)(p.in[I_STATE] + base + dv0);
                    f32x4 o; o.x = dc * s0.x + acc[4 * g4]; o.y = dc * s0.y + acc[4 * g4 + 1]; o.z = dc * s0.z + acc[4 * g4 + 2]; o.w = dc * s0.w + acc[4 * g4 + 3];
                    *(f32x4*)(p.out + O_SS + base + dv0) = o; }
            }
        }
        __syncthreads();
    }
#undef HA_LOAD
}
DI void hgrn_scan(const Params& p, int tid) {
    unsigned char* ws = p.ws;
    const bf16_t* UT = (const bf16_t*)(ws + WS_UT); const float* DEC = (const float*)(ws + WS_DEC); bf16_t* ST = (bf16_t*)(p.out + O_KP);
    for (int e2 = blockIdx.x * 512 + tid; e2 < 2 * 8 * 128 * 64; e2 += gridDim.x * 512) {
        const int bh = e2 >> 13, rem = e2 & 8191, dv = rem >> 6, dk2 = (rem & 63) * 2, b = bh >> 3, hh = bh & 7;
        f32x2 S = {0.f, 0.f};
#pragma unroll 8
        for (int c = 0; c < 256; ++c) {
            const int cgi = b * 256 + c; const size_t base = ((size_t)(cgi * 8 + hh) * 128 + dv) * 128 + dk2;
            const unsigned uw = *(const unsigned*)(UT + base); const f32x2 u = {bflo(uw), bfhi(uw)}; const f32x2 dc = *(const f32x2*)(DEC + (size_t)(cgi * 8 + hh) * 128 + dk2);
            *(unsigned*)(ST + base) = pk2(S.x, S.y);
            S = dc * S + u;
        }
        float* o = p.out + O_SP + ((size_t)(b * 8 + hh) * 128 + dk2) * 128 + dv;
        o[0] = S.x; o[128] = S.y;
    }
}
DI void hgrn_c(const Params& p, ldsp lds, int tid, int lane, int wave) {
    unsigned char* ws = p.ws;
    const bf16_t* G = (const bf16_t*)(ws + WS_G); const bf16_t* VB = (const bf16_t*)(ws + WS_VB); const bf16_t* QB = (const bf16_t*)(ws + WS_QB); const bf16_t* GATE = (const bf16_t*)(ws + WS_GATE);
    const bf16_t* ST = (const bf16_t*)(p.out + O_KP); bf16_t* OB = (bf16_t*)(ws + WS_OB); const float* gn = p.in[I_GNORM];
    LAS float* TOT = (LAS float*)(lds + 105472); LAS float* RED = (LAS float*)(lds + 107520);
    LAS bf16_t* QT = (LAS bf16_t*)(lds); LAS bf16_t* KT = (LAS bf16_t*)(lds + 17408); LAS bf16_t* QH = (LAS bf16_t*)(lds + 34816); LAS bf16_t* STl = (LAS bf16_t*)(lds + 70656);
    const int d = tid & 127, tq = tid >> 7, r = lane & 31, h = lane >> 5;
    const int dvb = wave & 3, tb = wave >> 2;
    float gv[16]; unsigned short vv[16], qq[16]; u32x4 stg[4];
#define HC_LOAD(u_) do { const int cg_ = (u_) >> 3, hh_ = (u_) & 7; const size_t o_ = (size_t)(cg_ * 64 + 16 * tq) * 1024 + hh_ * 128 + d; \
        _Pragma("unroll") for (int i = 0; i < 16; ++i) { gv[i] = bf2f(G[o_ + (size_t)i * 1024]); vv[i] = VB[o_ + (size_t)i * 1024]; qq[i] = QB[o_ + (size_t)i * 1024]; } \
        if (cg_ < NCHP) { const bf16_t* sp_ = ST + (size_t)(cg_ * 8 + hh_) * 16384; \
            _Pragma("unroll") for (int i = 0; i < 4; ++i) { const int idx_ = tid + 512 * i; stg[i] = *(const u32x4*)(sp_ + (idx_ >> 4) * 128 + (idx_ & 15) * 8); } } } while (0)
    int unit = blockIdx.x;
    if (unit < NCHUNK * 8) HC_LOAD(unit);
    for (; unit < NCHUNK * 8; unit += gridDim.x) {
        const int cgi = unit >> 3, hh = unit & 7, row0 = cgi * 64;
        const size_t orow = (size_t)(row0 + 32 * tb + r) * 1024 + hh * 128;
        u32x2 gt[4];
#pragma unroll
        for (int g4 = 0; g4 < 4; ++g4) gt[g4] = *(const u32x2*)(GATE + orow + 32 * dvb + 8 * g4 + 4 * h);
        float bl[16];
        { float c = 0.f;
#pragma unroll
          for (int i = 0; i < 16; ++i) { c += gv[i]; bl[i] = c; }
          TOT[tq * 128 + d] = c; }
        if (cgi < NCHP) {
#pragma unroll
            for (int i = 0; i < 4; ++i) { const int idx = tid + 512 * i, dv = idx >> 4, c8 = idx & 15; *(LAS u32x4*)(lds + 70656 + dv * 272 + c8 * 16) = stg[i]; }
        } else {
            const float* sp = p.in[I_STATE] + (size_t)((cgi - NCHP) * 8 + hh) * 16384;
#pragma unroll 8
            for (int i = 0; i < 32; ++i) { const int e = tid + 512 * i, dk = e >> 7, dv = e & 127; STl[dv * 136 + dk] = f2bf(sp[e]); }
        }
        __syncthreads();
        { float off = 0.f;
#pragma unroll
          for (int j = 0; j < 4; ++j) { const float t = TOT[j * 128 + d]; if (j < tq) off += t; }
          const float bmid = TOT[d] + TOT[128 + d];
#pragma unroll
          for (int i = 0; i < 16; ++i) { const int t = 16 * tq + i; const float bt = bl[i] + off, kk = 1.f - __expf(gv[i]), qv = bf2f(qq[i]);
              QT[t * 136 + d] = f2bf(qv * __expf(bt - bmid)); KT[t * 136 + d] = f2bf(kk * __expf(bmid - bt)); QH[t * 136 + d] = f2bf(qv * __expf(bt)); }
          u32x4 x0, x1;
          x0.x = vv[0] | ((unsigned)vv[1] << 16); x0.y = vv[2] | ((unsigned)vv[3] << 16); x0.z = vv[4] | ((unsigned)vv[5] << 16); x0.w = vv[6] | ((unsigned)vv[7] << 16);
          x1.x = vv[8] | ((unsigned)vv[9] << 16); x1.y = vv[10] | ((unsigned)vv[11] << 16); x1.z = vv[12] | ((unsigned)vv[13] << 16); x1.w = vv[14] | ((unsigned)vv[15] << 16);
          *(LAS u32x4*)(lds + 52224 + d * 144 + tq * 32) = x0; *(LAS u32x4*)(lds + 52224 + d * 144 + tq * 32 + 16) = x1; }
        if (unit + (int)gridDim.x < NCHUNK * 8) HC_LOAD(unit + (int)gridDim.x);
        __syncthreads();
        f32x16 o = zero16();
        for (int sb = 0; sb <= tb; ++sb) {
            f32x16 sc = zero16();
#pragma unroll
            for (int ks = 0; ks < 8; ++ks) {
                const bf16x8 a = *(const LAS bf16x8*)(lds + 17408 + (32 * sb + r) * 272 + (16 * ks + 8 * h) * 2);
                const bf16x8 b = *(const LAS bf16x8*)(lds + (32 * tb + r) * 272 + (16 * ks + 8 * h) * 2);
                sc = mfma32(a, b, sc);
            }
            if (sb == tb) {
#pragma unroll
                for (int reg = 0; reg < 16; ++reg) if (crow(reg, h) > r) sc[reg] = 0.f;
            }
#pragma unroll
            for (int s2 = 0; s2 < 2; ++s2) {
                const int kb = 32 * sb + 16 * s2 + 4 * h;
                const s16x4 lo = *(const LAS s16x4*)(lds + 52224 + (32 * dvb + r) * 144 + kb * 2);
                const s16x4 hi = *(const LAS s16x4*)(lds + 52224 + (32 * dvb + r) * 144 + (kb + 8) * 2);
                const bf16x8 a = (bf16x8){lo[0], lo[1], lo[2], lo[3], hi[0], hi[1], hi[2], hi[3]};
                o = mfma32(a, pack8(sc, s2), o);
            }
        }
#pragma unroll
        for (int ks = 0; ks < 8; ++ks) {
            const bf16x8 a = *(const LAS bf16x8*)(lds + 70656 + (32 * dvb + r) * 272 + (16 * ks + 8 * h) * 2);
            const bf16x8 b = *(const LAS bf16x8*)(lds + 34816 + (32 * tb + r) * 272 + (16 * ks + 8 * h) * 2);
            o = mfma32(a, b, o);
        }
        float ssq = 0.f;
#pragma unroll
        for (int reg = 0; reg < 16; ++reg) ssq += o[reg] * o[reg];
        ssq += __shfl_xor(ssq, 32);
        if (h == 0) RED[(tb * 4 + dvb) * 32 + r] = ssq;
        __syncthreads();
        const float tot = (RED[(tb * 4 + 0) * 32 + r] + RED[(tb * 4 + 1) * 32 + r]) + (RED[(tb * 4 + 2) * 32 + r] + RED[(tb * 4 + 3) * 32 + r]);
        const float rn = rsqrtf(tot * (1.f / 128.f) + EPS);
#pragma unroll
        for (int g4 = 0; g4 < 4; ++g4) { const int dv0 = 32 * dvb + 8 * g4 + 4 * h;
            const f32x4 gg = *(const f32x4*)(gn + dv0);
            u32x2 w; w.x = pk2(o[4 * g4] * rn * gg.x * bflo(gt[g4].x), o[4 * g4 + 1] * rn * gg.y * bfhi(gt[g4].x)); w.y = pk2(o[4 * g4 + 2] * rn * gg.z * bflo(gt[g4].y), o[4 * g4 + 3] * rn * gg.w * bfhi(gt[g4].y));
            *(u32x2*)(OB + orow + dv0) = w; }
        __syncthreads();
    }
#undef HC_LOAD
}

constexpr int A_KB0 = 0, A_KBS = 17408, A_VB0 = 34816, A_VBS = 20480, A_ITEM = 76800;
DI void a_ld_bf(u32x4& a, u32x4& b, const bf16_t* T, int rowbase, int kvh, int tid) {
    const int k0 = tid >> 4, c8 = tid & 15;
    a = *(const u32x4*)(T + (size_t)(rowbase + k0) * 512 + kvh * 128 + c8 * 8); b = *(const u32x4*)(T + (size_t)(rowbase + 32 + k0) * 512 + kvh * 128 + c8 * 8);
}
DI void a_st_bf(ldsp buf, int stride, const u32x4& a, const u32x4& b, int tid) {
    const int k0 = tid >> 4, c8 = tid & 15;
    *(LAS u32x4*)(buf + k0 * stride + c8 * 16) = a; *(LAS u32x4*)(buf + (32 + k0) * stride + c8 * 16) = b;
}
DI void a_ld_f32(u32x4 (&st)[4], const float* C, int ctile, int tid) {
    const int k0 = tid >> 5, c4 = tid & 31;
#pragma unroll
    for (int i = 0; i < 4; ++i) st[i] = *(const u32x4*)(C + (size_t)(ctile * 64 + 16 * i + k0) * 512 + c4 * 4);
}
DI void a_st_f32(ldsp buf, int stride, const u32x4 (&st)[4], int tid) {
    const int k0 = tid >> 5, c4 = tid & 31;
#pragma unroll
    for (int i = 0; i < 4; ++i) { u32x2 w; w.x = pk2(__uint_as_float(st[i].x), __uint_as_float(st[i].y)); w.y = pk2(__uint_as_float(st[i].z), __uint_as_float(st[i].w));
        *(LAS u32x2*)(buf + (16 * i + k0) * stride + c4 * 8) = w; }
}
DI void a_qk(f32x16& p0, f32x16& p1, ldsp kb, int koff, const bf16x8 (&qr)[4]) {
    const f32x16 z = zero16();
#pragma unroll
    for (int d0 = 0; d0 < 4; ++d0) {
        const bf16x8 a0 = *(const LAS bf16x8*)(kb + koff + d0 * 32);
        const bf16x8 a1 = *(const LAS bf16x8*)(kb + koff + 32 * 272 + d0 * 32);
        p0 = mfma32(a0, qr[d0], d0 ? p0 : z); p1 = mfma32(a1, qr[d0], d0 ? p1 : z);
    }
}
DI float a_rowmax(const f32x16& p0, const f32x16& p1) {
    float a = fmaxf(fmaxf(p0[0], p0[1]), p1[0]), b = fmaxf(fmaxf(p0[2], p0[3]), p1[1]), c = fmaxf(fmaxf(p0[4], p0[5]), p1[2]), d = fmaxf(fmaxf(p0[6], p0[7]), p1[3]);
    a = fmaxf(fmaxf(a, p0[8]), p1[4]); b = fmaxf(fmaxf(b, p0[9]), p1[5]); c = fmaxf(fmaxf(c, p0[10]), p1[6]); d = fmaxf(fmaxf(d, p0[11]), p1[7]);
    a = fmaxf(fmaxf(a, p0[12]), p1[8]); b = fmaxf(fmaxf(b, p0[13]), p1[9]); c = fmaxf(fmaxf(c, p0[14]), p1[10]); d = fmaxf(fmaxf(d, p0[15]), p1[11]);
    a = fmaxf(fmaxf(a, p1[12]), p1[13]); b = fmaxf(fmaxf(b, p1[14]), p1[15]);
    float m = fmaxf(fmaxf(a, b), fmaxf(c, d));
    return fmaxf(m, __shfl_xor(m, 32));
}
struct AttnCtx { int tid, kvh, kbase, bs, nt; const float* ckp; const float* cvp; const bf16_t* KB; const bf16_t* VB2; int koff, tr_off, h; };
constexpr int F_KB0 = 0, F_KBS = 17408, F_VB0 = 34816, F_VBS = 20480;
DI void a_unit_fp(const Params& p, const AttnCtx& c, ldsp lds, f32x16 (&o)[4], const bf16x8 (&qr)[4], float& mrun, float& lrun, int mm, int lane) {
    const int tid = c.tid, kvh = c.kvh, kbase = c.kbase, bs = c.bs, ncache = 64, nt = 65, r = lane & 31, h = lane >> 5;
    const bf16_t* KB = c.KB; const bf16_t* VB2 = c.VB2;
    const int tr_off = (((lane & 15) >> 2)) * 320 + (16 * ((lane >> 4) & 1) + 4 * (lane & 3)) * 2;
    constexpr int A_KB0 = F_KB0, A_KBS = F_KBS, A_VB0 = F_VB0, A_VBS = F_VBS;
        mrun = -1e30f; lrun = 0.f;
        u32x4 st[8];
        const float* ckp = p.in[I_CK] + ((size_t)bs * 4096 * 4 + kvh) * 128; const float* cvp = p.in[I_CV] + ((size_t)bs * 4096 * 4 + kvh) * 128;
#define A_LOAD(t) do { if ((t) < ncache) { _Pragma("unroll") for (int i_ = 0; i_ < 4; ++i_) { const int key_ = tid >> 3, c4_ = (tid & 7) * 4 + i_; const size_t so_ = (size_t)((t) * 64 + key_) * 512 + c4_ * 4; \
                st[i_] = *(const u32x4*)(ckp + so_); st[4 + i_] = *(const u32x4*)(cvp + so_); } } \
            else { _Pragma("unroll") for (int i_ = 0; i_ < 2; ++i_) { const int key_ = tid >> 3, c8_ = (tid & 7) * 2 + i_; const size_t so_ = (size_t)(kbase + ((t) - ncache) * 64 + key_) * 512 + kvh * 128 + c8_ * 8; \
                st[i_] = *(const u32x4*)(KB + so_); st[2 + i_] = *(const u32x4*)(VB2 + so_); } } } while (0)
#define A_STORE(t) do { const int kb_ = A_KB0 + ((t) & 1) * A_KBS, vb_ = A_VB0 + ((t) & 1) * A_VBS; \
            if ((t) < ncache) { _Pragma("unroll") for (int i_ = 0; i_ < 4; ++i_) { const int key_ = tid >> 3, c4_ = (tid & 7) * 4 + i_; \
                u32x2 a_, b_; a_.x = pk2(__uint_as_float(st[i_].x), __uint_as_float(st[i_].y)); a_.y = pk2(__uint_as_float(st[i_].z), __uint_as_float(st[i_].w)); \
                b_.x = pk2(__uint_as_float(st[4 + i_].x), __uint_as_float(st[4 + i_].y)); b_.y = pk2(__uint_as_float(st[4 + i_].z), __uint_as_float(st[4 + i_].w)); \
                *(LAS u32x2*)(lds + kb_ + key_ * 272 + c4_ * 8) = a_; *(LAS u32x2*)(lds + vb_ + key_ * 320 + c4_ * 8) = b_; } } \
            else { _Pragma("unroll") for (int i_ = 0; i_ < 2; ++i_) { const int key_ = tid >> 3, c8_ = (tid & 7) * 2 + i_; \
                *(LAS u32x4*)(lds + kb_ + key_ * 272 + c8_ * 16) = st[i_]; *(LAS u32x4*)(lds + vb_ + key_ * 320 + c8_ * 16) = st[2 + i_]; } } } while (0)
        A_LOAD(0);
        A_STORE(0);
        __syncthreads();
        for (int t = 0; t < nt; ++t) {
            if (t + 1 < nt) A_LOAD(t + 1);
            const int kb = A_KB0 + (t & 1) * A_KBS, vb = A_VB0 + (t & 1) * A_VBS;
            f32x16 p0 = zero16(), p1 = zero16();
#pragma unroll
            for (int d0 = 0; d0 < 4; ++d0) {
                const bf16x8 a0 = *(const LAS bf16x8*)(lds + kb + r * 272 + (mm * 64 + 16 * d0 + 8 * h) * 2);
                const bf16x8 a1 = *(const LAS bf16x8*)(lds + kb + (32 + r) * 272 + (mm * 64 + 16 * d0 + 8 * h) * 2);
                p0 = mfma32(a0, qr[d0], p0); p1 = mfma32(a1, qr[d0], p1);
            }
            float mx = fmaxf(p0[0], p1[0]);
#pragma unroll
            for (int i = 1; i < 16; ++i) mx = fmaxf(mx, fmaxf(p0[i], p1[i]));
            mx = fmaxf(mx, __shfl_xor(mx, 32));
            if (__any(mx > mrun + 8.f)) {
                const float mn = fmaxf(mrun, mx), al = __builtin_amdgcn_exp2f(mrun - mn);
                lrun *= al; mrun = mn;
#pragma unroll
                for (int i = 0; i < 4; ++i)
#pragma unroll
                    for (int j = 0; j < 16; ++j) o[i][j] *= al;
            }
            float ls = 0.f;
#pragma unroll
            for (int i = 0; i < 16; ++i) { p0[i] = __builtin_amdgcn_exp2f(p0[i] - mrun); p1[i] = __builtin_amdgcn_exp2f(p1[i] - mrun); ls += p0[i] + p1[i]; }
            lrun += ls;
            bf16x8 pk[4]; pk[0] = pack8(p0, 0); pk[1] = pack8(p0, 1); pk[2] = pack8(p1, 0); pk[3] = pack8(p1, 1);
#pragma unroll
            for (int s = 0; s < 4; ++s) {
                const int keyb = 32 * (s >> 1) + 16 * (s & 1) + 4 * h;
#pragma unroll
                for (int db = 0; db < 4; ++db) {
                    const s16x4 lo = vtr(lds + vb + keyb * 320 + db * 64 + tr_off);
                    const s16x4 hi = vtr(lds + vb + (keyb + 8) * 320 + db * 64 + tr_off);
                    const bf16x8 a = (bf16x8){lo[0], lo[1], lo[2], lo[3], hi[0], hi[1], hi[2], hi[3]};
                    o[db] = mfma32(a, pk[s], o[db]);
                }
            }
            if (t + 1 < nt) A_STORE(t + 1);
            __syncthreads();
        }
#undef A_LOAD
#undef A_STORE
}
constexpr int B_K0 = 0, B_V0 = 32768, B_TS = 16384;
DI void a_dma_tile(ldsp dst, const bf16_t* T, int rowbase, int kvh, int wave, int lane, bool isV) {
#pragma unroll
    for (int i = 0; i < 2; ++i) {
        const int j = wave + 8 * i, row = 4 * j + (lane >> 4), pc = lane & 15, cch = isV ? (pc ^ ((row & 3) << 2)) : (pc ^ (row & 15));
        __builtin_amdgcn_global_load_lds((const unsigned*)(T + (size_t)(rowbase + row) * 512 + kvh * 128 + cch * 8), (LAS unsigned*)(dst + j * 1024), 16, 0, 0);
    }
}
DI void b_qk(f32x16& p0, f32x16& p1, ldsp kb, int koff, const bf16x8 (&qr)[4], const f32x16& z) {
#pragma unroll
    for (int d0 = 0; d0 < 4; ++d0) {
        const bf16x8 a0 = *(const LAS bf16x8*)(kb + (koff ^ (d0 * 32)));
        const bf16x8 a1 = *(const LAS bf16x8*)(kb + (koff ^ (d0 * 32)) + 8192);
        p0 = mfma32(a0, qr[d0], d0 ? p0 : z); p1 = mfma32(a1, qr[d0], d0 ? p1 : z);
    }
}
#define SB() __builtin_amdgcn_sched_barrier(0)
DI void b_vfrag(s16x4 (&f)[8], ldsp vb, const int (&trb)[4], int s) {
    const int kimm = (32 * (s >> 1) + 16 * (s & 1)) * 256;
#pragma unroll
    for (int db = 0; db < 4; ++db) { f[2 * db] = vtr(vb + trb[db] + kimm); f[2 * db + 1] = vtr(vb + trb[db] + kimm + 8 * 256); }
}
DI void b_pv(f32x16 (&o)[4], const s16x4 (&f)[8], bf16x8 pk) {
#pragma unroll
    for (int db = 0; db < 4; ++db) { const s16x4 lo = f[2 * db], hi = f[2 * db + 1];
        o[db] = mfma32((bf16x8){lo[0], lo[1], lo[2], lo[3], hi[0], hi[1], hi[2], hi[3]}, pk, o[db]); }
}
DI void b_step(const AttnCtx& c, ldsp lds, int wave, int lane, int t, f32x16& S0, f32x16& S1, f32x16& N0, f32x16& N1, f32x16 (&o)[4], const bf16x8 (&qr)[4], const int (&trb)[4], f32x16& negm, float& lrun) {
    const int tK = min(t + 2, c.nt - 1), tV = min(t + 1, c.nt - 1);
    const bool hasN = t + 1 < c.nt;
    a_dma_tile(lds + B_K0 + (t & 1) * B_TS, c.KB, c.kbase + tK * 64, c.kvh, wave, lane, false);
    a_dma_tile(lds + B_V0 + ((t + 1) & 1) * B_TS, c.VB2, c.kbase + tV * 64, c.kvh, wave, lane, true);
    const ldsp kb = lds + B_K0 + ((t + 1) & 1) * B_TS, vb = lds + B_V0 + (t & 1) * B_TS;
    bf16x8 ka[4], kc[4]; s16x4 f0[8], f1[8]; bf16x8 pk0, pk1, pk2, pk3; float ls = 0.f;
    ka[0] = *(const LAS bf16x8*)(kb + c.koff); ka[1] = *(const LAS bf16x8*)(kb + c.koff + 8192); ka[2] = *(const LAS bf16x8*)(kb + (c.koff ^ 32)); ka[3] = *(const LAS bf16x8*)(kb + (c.koff ^ 32) + 8192);
    SB();
    N0 = mfma32(ka[0], qr[0], negm); N1 = mfma32(ka[1], qr[0], negm); N0 = mfma32(ka[2], qr[1], N0); N1 = mfma32(ka[3], qr[1], N1);
    kc[0] = *(const LAS bf16x8*)(kb + (c.koff ^ 64)); kc[1] = *(const LAS bf16x8*)(kb + (c.koff ^ 64) + 8192); kc[2] = *(const LAS bf16x8*)(kb + (c.koff ^ 96)); kc[3] = *(const LAS bf16x8*)(kb + (c.koff ^ 96) + 8192);
#pragma unroll
    for (int i = 0; i < 16; ++i) { S0[i] = __builtin_amdgcn_exp2f(S0[i]); ls += S0[i]; }
    SB();
    N0 = mfma32(kc[0], qr[2], N0); N1 = mfma32(kc[1], qr[2], N1); N0 = mfma32(kc[2], qr[3], N0); N1 = mfma32(kc[3], qr[3], N1);
    b_vfrag(f0, vb, trb, 0);
    pk0 = pack8(S0, 0); pk1 = pack8(S0, 1);
#pragma unroll
    for (int i = 0; i < 8; ++i) { S1[i] = __builtin_amdgcn_exp2f(S1[i]); ls += S1[i]; }
    SB();
    __builtin_amdgcn_s_setprio(1);
    b_pv(o, f0, pk0);
    b_vfrag(f1, vb, trb, 1);
#pragma unroll
    for (int i = 8; i < 16; ++i) { S1[i] = __builtin_amdgcn_exp2f(S1[i]); ls += S1[i]; }
    SB();
    b_pv(o, f1, pk1);
    b_vfrag(f0, vb, trb, 2);
    pk2 = pack8(S1, 0); pk3 = pack8(S1, 1);
    lrun += ls;
    SB();
    b_pv(o, f0, pk2);
    b_vfrag(f1, vb, trb, 3);
    float mx = a_rowmax(N0, N1); mx = hasN ? mx : -1e30f;
    SB();
    b_pv(o, f1, pk3);
    __builtin_amdgcn_s_setprio(0);
    SB();
    if (__any(mx > 8.f)) {
        const float dl = fmaxf(mx, 0.f), al = __builtin_amdgcn_exp2f(-dl);
        lrun *= al;
#pragma unroll
        for (int i = 0; i < 4; ++i)
#pragma unroll
            for (int j = 0; j < 16; ++j) o[i][j] *= al;
#pragma unroll
        for (int j = 0; j < 16; ++j) { N0[j] -= dl; N1[j] -= dl; negm[j] -= dl; }
    }
    __syncthreads();
}
DI void a_unit_bf(const AttnCtx& c, ldsp lds, int wave, int lane, int mm, f32x16 (&o)[4], const bf16x8 (&qr)[4], float& mrun, float& lrun) {
    const int r = lane & 31, h = lane >> 5, q = (lane & 15) >> 2, pp = lane & 3, g16 = (lane >> 4) & 1;
    int trb[4];
#pragma unroll
    for (int db = 0; db < 4; ++db) trb[db] = (4 * h + q) * 256 + (4 * (db ^ q) + 2 * g16 + (pp >> 1)) * 16 + 8 * (pp & 1);
    AttnCtx cc = c; cc.koff = r * 256 + (((8 * mm + h) ^ (r & 15)) * 16);
    a_dma_tile(lds + B_K0, c.KB, c.kbase, c.kvh, wave, lane, false);
    a_dma_tile(lds + B_V0, c.VB2, c.kbase, c.kvh, wave, lane, true);
    a_dma_tile(lds + B_K0 + B_TS, c.KB, c.kbase + min(1, c.nt - 1) * 64, c.kvh, wave, lane, false);
    __syncthreads();
    f32x16 A0, A1, B0, B1, negm;
    b_qk(A0, A1, lds + B_K0, cc.koff, qr, zero16());
    mrun = a_rowmax(A0, A1); lrun = 0.f;
#pragma unroll
    for (int j = 0; j < 16; ++j) { A0[j] -= mrun; A1[j] -= mrun; negm[j] = -mrun; }
    for (int t = 0; t < c.nt; t += 2) {
        b_step(cc, lds, wave, lane, t, A0, A1, B0, B1, o, qr, trb, negm, lrun);
        if (t + 1 < c.nt) b_step(cc, lds, wave, lane, t + 1, B0, B1, A0, A1, o, qr, trb, negm, lrun);
    }
}
DI void attn_phase(const Params& p, ldsp lds, int tid0, int lane0, int wave) {
    unsigned char* ws = p.ws;
    const bf16_t* QB2 = (const bf16_t*)(ws + WS_QB); bf16_t* OB = (bf16_t*)(ws + WS_OB);
    unsigned* qhead = (unsigned*)(ws + WS_CTL);
    const int th = wave & 1, g = (wave >> 1) & 1, mm = wave >> 2;
    const int x = blockIdx.x & 7;
    float lam;
    { const float a = p.in[I_LQ1][lane0] * p.in[I_LK1][lane0], b = p.in[I_LQ2][lane0] * p.in[I_LK2][lane0]; lam = __expf(wave_sum(a)) - __expf(wave_sum(b)) + LAM_INIT; }
    for (;;) {
        int lane = lane0; asm volatile("" : "+v"(lane));
        const int tid = (wave << 6) | lane, r = lane & 31, h = lane >> 5;
        AttnCtx c; c.tid = tid; c.h = h; c.KB = (const bf16_t*)(ws + WS_KB); c.VB2 = (const bf16_t*)(ws + WS_VB2); c.koff = 0; c.tr_off = 0;
        if (tid == 0) *(LAS unsigned*)(lds + A_ITEM) = __hip_atomic_fetch_add(qhead + x * 64, 1u, __ATOMIC_RELAXED, __HIP_MEMORY_SCOPE_AGENT);
        __syncthreads();
        const int item = (int)*(LAS unsigned*)(lds + A_ITEM);
        if (item >= 16 + 256) break;
        int qrow0; bool fp;
        if (item < 16) { c.bs = x * 4 + (item >> 2); c.kvh = item & 3; qrow0 = MP + c.bs * 64; c.kbase = qrow0; fp = true; c.nt = 65; }
        else { const int b = x >> 2, qc = 255 - (item - 16); c.bs = 0; c.kvh = x & 3; qrow0 = b * 16384 + qc * 64; c.kbase = b * 16384; fp = false; c.nt = qc + 1; }
        c.ckp = p.in[I_CK] + ((size_t)c.bs * 4096 * 4 + c.kvh) * 128; c.cvp = p.in[I_CV] + ((size_t)c.bs * 4096 * 4 + c.kvh) * 128;
        const int hq = c.kvh * 2 + g;
        bf16x8 qr[4];
        { const bf16_t* qp = QB2 + (size_t)(qrow0 + 32 * th + r) * 1024 + hq * 128 + mm * 64 + 8 * h;
#pragma unroll
          for (int d0 = 0; d0 < 4; ++d0) qr[d0] = *(const bf16x8*)(qp + 16 * d0); }
        f32x16 o[4];
#pragma unroll
        for (int i = 0; i < 4; ++i) o[i] = zero16();
        float mrun, lrun;
        if (fp) a_unit_fp(p, c, lds, o, qr, mrun, lrun, mm, lane); else a_unit_bf(c, lds, wave, lane, mm, o, qr, mrun, lrun);
        lrun += __shfl_xor(lrun, 32);
        const float inv = __builtin_amdgcn_rcpf(lrun);
        LAS float* cmb = (LAS float*)(lds) + (size_t)(g * 2 + th) * 4096 + lane;
        if (mm == 1) {
            const float sc = lam * inv;
#pragma unroll
            for (int i = 0; i < 4; ++i)
#pragma unroll
                for (int j = 0; j < 16; ++j) cmb[(i * 16 + j) * 64] = o[i][j] * sc;
        }
        __syncthreads();
        if (mm == 0) {
            float ssq = 0.f;
#pragma unroll
            for (int i = 0; i < 4; ++i)
#pragma unroll
                for (int j = 0; j < 16; ++j) { const float v = o[i][j] * inv - cmb[(i * 16 + j) * 64]; o[i][j] = v; ssq += v * v; }
            ssq += __shfl_xor(ssq, 32);
            const float rn = rsqrtf(ssq * (1.f / 128.f) + EPS) * (1.f - LAM_INIT);
            bf16_t* op = OB + (size_t)(qrow0 + 32 * th + r) * 1024 + hq * 128;
#pragma unroll
            for (int i = 0; i < 4; ++i)
#pragma unroll
                for (int g4 = 0; g4 < 4; ++g4) { const int dv0 = 32 * i + 8 * g4 + 4 * h; const f32x4 gg = *(const f32x4*)(p.in[I_SUBLN] + dv0);
                    u32x2 w; w.x = pk2(o[i][4 * g4] * rn * gg.x, o[i][4 * g4 + 1] * rn * gg.y); w.y = pk2(o[i][4 * g4 + 2] * rn * gg.z, o[i][4 * g4 + 3] * rn * gg.w);
                    *(u32x2*)(op + dv0) = w; }
        }
        __syncthreads();
    }
}

#define XB_TMO      128
#define XB_XCNT(j)  (256  + 64 * (j))
#define XB_XSUB(j)  (1280 + 64 * (j))
#define XB_XGEN(j)  (2304 + 64 * (j))
#define XB_TOP      3328
#define XB_TOPGEN   3392
#define XCD_BAR_WORDS 3456
#define XB_SPIN_CAP (1u << 18)

__device__ __forceinline__ unsigned xb_ld(unsigned* p)              { return __hip_atomic_load(p, __ATOMIC_RELAXED, __HIP_MEMORY_SCOPE_AGENT); }
__device__ __forceinline__ unsigned xb_add(unsigned* p, unsigned v) { return __hip_atomic_fetch_add(p, v, __ATOMIC_RELAXED, __HIP_MEMORY_SCOPE_AGENT); }
__device__ __forceinline__ unsigned xb_xcc_id() { return (unsigned)__builtin_amdgcn_s_getreg((3 << 11) | 20) & 0xFu; }
#define XB_SPIN(cond, bar) do { unsigned _sp = 0; while (cond) { __builtin_amdgcn_s_sleep(1); \
    if ((++_sp & 255u) == 0u) { if (xb_ld(&(bar)[XB_TMO])) break; if (_sp > XB_SPIN_CAP) { atomicAdd(&(bar)[XB_TMO], 1u); break; } } } } while (0)

struct XcdBarrier {
    unsigned* bar; unsigned x;
    volatile LAS unsigned* st;
};

__device__ __forceinline__ XcdBarrier xcd_barrier_post(unsigned* bar, volatile LAS unsigned* st) {
    XcdBarrier b; b.bar = bar; b.x = xb_xcc_id(); b.st = st;
    if (threadIdx.x == 0) (void)xb_add(&bar[XB_XCNT(b.x)], 1u);
    return b;
}
__device__ __forceinline__ void xcd_barrier_complete(unsigned* bar, unsigned x, unsigned& nloc, unsigned& nx) {
    const unsigned G = gridDim.x * gridDim.y * gridDim.z;
    unsigned sum, cnt, mine, sp = 0u;
    for (;;) {
        sum = 0u; cnt = 0u; mine = 0u;
#pragma unroll
        for (unsigned j = 0; j < 16; ++j) { const unsigned c = xb_ld(&bar[XB_XCNT(j)]); sum += c; cnt += (c > 0u) ? 1u : 0u; mine = (j == x) ? c : mine; }
        if (sum == G) break;
        __builtin_amdgcn_s_sleep(1);
        if ((++sp & 255u) == 0u) { if (xb_ld(&bar[XB_TMO])) break; if (sp > XB_SPIN_CAP) { atomicAdd(&bar[XB_TMO], 1u); break; } }
    }
    nloc = mine > 0u ? mine : 1u; nx = cnt > 0u ? cnt : 1u;
}

__device__ __forceinline__ void xcd_barrier(const XcdBarrier& b) {
    asm volatile("s_waitcnt vmcnt(0)" ::: "memory");
    __syncthreads();
    if (threadIdx.x == 0) {
        unsigned* bar = b.bar;
        __builtin_amdgcn_s_waitcnt(0);
        unsigned nloc = b.st[0], nx = b.st[1];
        if (nloc == 0u) { xcd_barrier_complete(bar, b.x, nloc, nx); b.st[0] = nloc; b.st[1] = nx; }
        const unsigned old = xb_add(&bar[XB_XSUB(b.x)], 1u);
        const unsigned gen = old / nloc;
        if (old + 1u == (gen + 1u) * nloc) {
            __builtin_amdgcn_fence(__ATOMIC_RELEASE, "agent");
            asm volatile("s_waitcnt vmcnt(0)" ::: "memory");
            const unsigned og = xb_add(&bar[XB_TOP], 1u);
            const unsigned tg = og / nx;
            if (og + 1u == (tg + 1u) * nx) xb_add(&bar[XB_TOPGEN], 1u);
            else XB_SPIN(xb_ld(&bar[XB_TOPGEN]) == tg, bar);
            __builtin_amdgcn_fence(__ATOMIC_ACQUIRE, "agent");
            xb_add(&bar[XB_XGEN(b.x)], 1u);
            asm volatile("s_waitcnt vmcnt(0)" ::: "memory");
        } else {
            XB_SPIN(xb_ld(&bar[XB_XGEN(b.x)]) == gen, bar);
            __builtin_amdgcn_fence(__ATOMIC_ACQUIRE, "agent");
            asm volatile("s_waitcnt vmcnt(0)" ::: "memory");
        }
    }
    __syncthreads();
}

struct SplitSched {
    int G, c;
    DI bool next(int i, Unit& u) const { const int L = i * G + c; if (L >= 256) return false; u.ko = (L & 7); u.pn = (L >> 3) & 3; u.pm = 128 + (L >> 5); return true; }
    DI void a_ready(const Unit&) const {}
    DI void done(const Unit&) const {}
};
struct EpiPart {
    static constexpr bool PERM = true, AFTER_DRAIN = false;
    float* PART; int kslice;
    DI void operator()(const f32x4 (&acc)[2][2][4][2], const Unit& u, int wr, int wc, int fr, int fq) const {
        const int cbase = u.pn * 256 + wc * 32 + 8 * fq; float* base = PART + (size_t)(u.ko / kslice) * 2048 * 1024;
#pragma unroll
        for (int ai = 0; ai < 2; ++ai)
#pragma unroll
            for (int m = 0; m < 4; ++m) {
                const int row = (u.pm - 128) * 256 + ai * 128 + wr * 64 + m * 16 + fr;
#pragma unroll
                for (int bj = 0; bj < 2; ++bj) { float* o = base + (size_t)row * 1024 + cbase + bj * 128; *(f32x4*)o = acc[ai][bj][m][0]; *(f32x4*)(o + 4) = acc[ai][bj][m][1]; }
            }
    }
};
struct SplitSchedK {
    int G, c, kslice;
    DI bool next(int i, Unit& u) const { const int L = i * G + c; if (L >= 256) return false; u.ko = (L & 7) * kslice; u.pn = (L >> 3) & 3; u.pm = 128 + (L >> 5); return true; }
    DI void a_ready(const Unit&) const {}
    DI void done(const Unit&) const {}
};
DI void run_gemm_mix(ldsp lds, unsigned char* ws, const bf16_t* A, const bf16_t* Bt, int K) {
    { pg8::Gemm g{A, Bt, MP, 1024, K, K}; pg8::StaticOrder S; S.init(MP, 1024, (int)gridDim.x, (int)blockIdx.x); EpiMix E{ws};
      pg8::gemm_phase<EpiMix, pg8::StaticOrder, true, true>(lds, g, S, E); }
    { pg8::Gemm g{A, Bt, M, 1024, K / 8, K}; SplitSchedK S{(int)gridDim.x, (int)blockIdx.x, K / 8}; EpiPart E{(float*)(ws + WS_QB), K / 8};
      pg8::gemm_phase<EpiPart, SplitSchedK, false, true>(lds, g, S, E); }
}
template <class Epi> DI void run_gemm(ldsp lds, const bf16_t* A, const bf16_t* Bt, int N, int K, const Epi& E) {
    pg8::Gemm g{A, Bt, M, N, K, K}; pg8::StaticOrder S; S.init(M, N, (int)gridDim.x, (int)blockIdx.x);
    pg8::gemm_phase<Epi, pg8::StaticOrder, true, true>(lds, g, S, E);
}
#ifndef MK_LAST_PHASE
#define MK_LAST_PHASE 99
#endif
__global__ void __launch_bounds__(512, 2) yoco_fwd(Params p) {
    extern __shared__ __attribute__((aligned(16))) unsigned char lds_raw[];
    cg::grid_group grid = cg::this_grid();
    ldsp lds = (ldsp)lds_raw;
    const int tid = threadIdx.x, lane = tid & 63, wave = __builtin_amdgcn_readfirstlane(tid >> 6);
    unsigned char* ws = p.ws;
    float* RINV = (float*)(ws + WS_RINV); bf16_t* XB = (bf16_t*)(ws + WS_XB); bf16_t* MIXB = (bf16_t*)(ws + WS_MIXB); bf16_t* OB = (bf16_t*)(ws + WS_OB); bf16_t* HB = (bf16_t*)(ws + WS_HB);
#define SEAM(k) xcd_barrier(bar)
#define PH(k) ((p.mask >> (k)) & 1u)
    volatile LAS unsigned* xst = (volatile LAS unsigned*)(lds + 147200);
    if (tid < 2) xst[tid] = 0u;
    phase0(p, lds, tid, lane, wave, PH(0));
    grid.sync();
    XcdBarrier bar = xcd_barrier_post((unsigned*)(ws + WS_CTL) + 4096, xst);
    if (PH(1)) { EpiIn E{ws, p.in[I_LB]}; run_gemm(lds, XB, (const bf16_t*)(ws + WS_WIN), 4096, 1024, E); }
    SEAM(1);
    if (PH(2)) hgrn_a(p, lds, tid, lane, wave);
    SEAM(2);
    if (PH(3)) hgrn_scan(p, tid);
    SEAM(3);
    if (PH(4)) hgrn_c(p, lds, tid, lane, wave);
    SEAM(4);
    if (PH(5)) run_gemm_mix(lds, ws, OB, (const bf16_t*)(ws + WS_WOA), 1024);
    SEAM(5);
    if (PH(6)) thin_phase<false, false>(p, p.in[I_NMIXPOST], lane, wave);
    SEAM(6);
    if (PH(7)) { EpiUp E{ws}; run_gemm(lds, XB, (const bf16_t*)(ws + WS_WUP0), 4096, 1024, E); }
    SEAM(7);
    if (PH(8)) run_gemm_mix(lds, ws, HB, (const bf16_t*)(ws + WS_WDN0), 4096);
    SEAM(8);
    if (PH(9)) thin_phase<false, false>(p, p.in[I_NMLPPOST], lane, wave);
    SEAM(9);
    if (PH(10)) { EpiKvq E{ws, p.out}; run_gemm(lds, XB, (const bf16_t*)(ws + WS_WKVQ), 2048, 1024, E); }
    SEAM(10);
    if (PH(11)) attn_phase(p, lds, tid, lane, wave);
    SEAM(11);
    if (PH(12)) run_gemm_mix(lds, ws, OB, (const bf16_t*)(ws + WS_WOB), 1024);
    SEAM(12);
    if (PH(13)) thin_phase<false, false>(p, p.in[I_NMIXPOST] + 1024, lane, wave);
    SEAM(13);
    if (PH(14)) { EpiUp E{ws}; run_gemm(lds, XB, (const bf16_t*)(ws + WS_WUP1), 4096, 1024, E); }
    SEAM(14);
    if (PH(15)) run_gemm_mix(lds, ws, HB, (const bf16_t*)(ws + WS_WDN1), 4096);
    SEAM(15);
    if (PH(16)) thin_phase<false, true>(p, p.in[I_NMLPPOST] + 1024, lane, wave);
#undef PH
#undef SEAM
}
}

extern "C" void kernel_launch(void* const* d_in, const int* in_sizes, int n_in, void* d_out, int out_size, void* d_ws, size_t ws_size, hipStream_t stream) {
    static int grid = 0;
    if (grid == 0) {
        if (n_in != 24 || ws_size < mk::WS_END) { fprintf(stderr, "kernel_launch: need 24 inputs and >= %zu bytes of workspace; got %d, %zu\n", (size_t)mk::WS_END, n_in, ws_size); grid = -1; return; }
        int dev = 0, cus = 0, per_cu = 0;
        if (hipGetDevice(&dev) != hipSuccess || hipDeviceGetAttribute(&cus, hipDeviceAttributeMultiprocessorCount, dev) != hipSuccess) { grid = -1; return; }
        if (hipFuncSetAttribute((const void*)mk::yoco_fwd, hipFuncAttributeMaxDynamicSharedMemorySize, mk::LDS_BYTES) != hipSuccess) { fprintf(stderr, "kernel_launch: hipFuncSetAttribute failed\n"); grid = -1; return; }
        if (hipOccupancyMaxActiveBlocksPerMultiprocessor(&per_cu, (const void*)mk::yoco_fwd, 512, mk::LDS_BYTES) != hipSuccess || per_cu < 1) { fprintf(stderr, "kernel_launch: occupancy query says %d\n", per_cu); per_cu = 1; }
        (void)hipGetLastError();
        grid = cus;
    }
    if (grid < 0) return;
    mk::Params prm{};
    for (int i = 0; i < 24; ++i) prm.in[i] = (const float*)d_in[i];
    prm.out = (float*)d_out; prm.ws = (unsigned char*)d_ws;
#if defined(MK_PROBE_MASK)
    { prm.mask = MK_PROBE_MASK; void* pa[] = {&prm}; (void)hipLaunchCooperativeKernel((const void*)mk::yoco_fwd, dim3(grid), dim3(512), pa, mk::LDS_BYTES, stream); }
#endif
    prm.mask = 0x1ffffu;
    void* args[] = {&prm};
    hipError_t e = hipLaunchCooperativeKernel((const void*)mk::yoco_fwd, dim3(grid), dim3(512), args, mk::LDS_BYTES, stream);
    if (e != hipSuccess) fprintf(stderr, "kernel_launch: cooperative launch failed: %s (grid %d)\n", hipGetErrorString(e), grid);
}
```

```cpp
#include <hip/hip_runtime.h>
#include <hip/hip_cooperative_groups.h>
#include <cstdio>
#include <cstdint>
namespace cg = cooperative_groups;

namespace pg8 {
#define PG8_LAS __attribute__((address_space(3)))
typedef unsigned short bf16_t;
typedef short bf16x8 __attribute__((ext_vector_type(8)));
typedef float f32x4 __attribute__((ext_vector_type(4)));
typedef unsigned u32x4 __attribute__((ext_vector_type(4)));
constexpr int BM = 256, BK = 64, HALF = 128, HTB = HALF * BK * 2  , STAGE_BYTES = 8 * HTB, NXCD = 8, WGM = 8;

__host__ __device__ __forceinline__ int lds_byte(int r, int c) { const int st = (r >> 4) * 2 + (c >> 5), rr = r & 15, cc = c & 31, ob = rr * 64 + cc * 2; return st * 1024 + (ob ^ (((ob >> 9) & 1) << 5)); }
__host__ __device__ __forceinline__ void stage_rc(int b, int& R, int& C) { const int st = b / 1024, sb = b % 1024, swz = sb ^ (((sb >> 9) & 1) << 5); R = (st >> 1) * 16 + swz / 64; C = (st & 1) * 32 + (swz % 64) / 2; }
__host__ __device__ __forceinline__ int perm32(int rho) { const int n = rho >> 4, i = rho & 15; return 8 * (i >> 2) + 4 * n + (i & 3); }

struct Unit { int pm, pn, ko; };
struct Gemm { const bf16_t* A; const bf16_t* Bt; int M, N, K, ld; };

struct StaticOrder {
    int nM, nN, nwg, G, c;
    __host__ __device__ void init(int M, int N, int G_, int c_) { nM = M / BM; nN = N / BM; nwg = nM * nN; G = G_; c = c_; }
    __host__ __device__ bool next(int i, Unit& u) const {
        const long L = (long)i * G + c; if (L >= nwg) return false;
        int wgid = (int)L; { const int q = nwg / NXCD, r = nwg % NXCD, xcd = wgid % NXCD, off = wgid / NXCD; wgid = (xcd < r ? xcd * (q + 1) : r * (q + 1) + (xcd - r) * q) + off; }
        const int nig = WGM * nN, gid = wgid / nig, fm = gid * WGM, gsz = (nM - fm) < WGM ? (nM - fm) : WGM;
        u.pm = fm + ((wgid % nig) % gsz); u.pn = (wgid % nig) / gsz; u.ko = 0; return true;
    }
    __device__ __forceinline__ void a_ready(const Unit&) const {}
    __device__ __forceinline__ void done(const Unit&) const {}
};

__device__ __forceinline__ unsigned cvt_pk_bf16(float lo, float hi) { unsigned r; asm volatile("v_cvt_pk_bf16_f32 %0, %1, %2" : "=v"(r) : "v"(lo), "v"(hi)); return r; }
template <class Epi, class Sched, bool ALIGN_EPI = false, bool SP2 = false>
__device__ __forceinline__ void gemm_phase(PG8_LAS unsigned char* lds, const Gemm g, const Sched& S, const Epi& E) {
    int tid = threadIdx.x; asm volatile("" : "+v"(tid));
    const int wid = __builtin_amdgcn_readfirstlane(tid >> 6), lane = tid & 63, wr = wid >> 2, wc = wid & 3, fr = lane & 15, fq = lane >> 4;
    const int K = g.K, nt = K / BK;
    unsigned voffA[2], voffB[2];
#pragma unroll
    for (int i = 0; i < 2; ++i) { int R, C; stage_rc(tid * 16 + i * 8192, R, C); const int Rb = Epi::PERM ? ((R & ~31) + perm32(R & 31)) : R;
        voffA[i] = (unsigned)(R * g.ld + C) * 2u; voffB[i] = (unsigned)(Rb * g.ld + C) * 2u; }
    const size_t kstep = (size_t)(BK * 2);
    const size_t hstep = (size_t)HALF * g.ld * 2;
    const size_t tstep = 2 * hstep;
    const unsigned ldsw = (unsigned)wid * 1024u;
    const int aoff = lds_byte(wr * 64 + fr, fq * 8), boff = lds_byte(wc * 32 + fr, fq * 8);
#define PG8_SA(b, h) (((b) * 2 + (h)) * HTB)
#define PG8_SB(b, h) ((4 + (b) * 2 + (h)) * HTB)
#define PG8_STAGE(bufoff, gbase, voff) do { _Pragma("unroll") for (int _i = 0; _i < 2; ++_i) \
        __builtin_amdgcn_global_load_lds((const unsigned*)((const char*)(gbase) + (voff)[_i]), (PG8_LAS unsigned*)(lds + (bufoff) + ldsw + _i * 8192), 16, 0, 0); } while (0)
#define PG8_LDA(dst, b, h) do { _Pragma("unroll") for (int m = 0; m < 4; ++m) _Pragma("unroll") for (int k = 0; k < 2; ++k) dst[m][k] = *(const PG8_LAS bf16x8*)(lds + PG8_SA(b, h) + aoff + m * 2048 + k * 1024); } while (0)
#define PG8_LDB(dst, b, h) do { _Pragma("unroll") for (int n = 0; n < 2; ++n) _Pragma("unroll") for (int k = 0; k < 2; ++k) dst[n][k] = *(const PG8_LAS bf16x8*)(lds + PG8_SB(b, h) + boff + n * 2048 + k * 1024); } while (0)
#define PG8_MMA(ai, bj, At, Bt) do { __builtin_amdgcn_s_setprio(1); _Pragma("unroll") for (int m = 0; m < 4; ++m) _Pragma("unroll") for (int n = 0; n < 2; ++n) _Pragma("unroll") for (int k = 0; k < 2; ++k) \
        acc[ai][bj][m][n] = __builtin_amdgcn_mfma_f32_16x16x32_bf16(Bt[n][k], At[m][k], acc[ai][bj][m][n], 0, 0, 0); __builtin_amdgcn_s_setprio(0); } while (0)
#define PG8_WAIT_V(n) asm volatile("s_waitcnt vmcnt(" #n ")" ::: "memory")
#define PG8_WAIT_L(n) asm volatile("s_waitcnt lgkmcnt(" #n ")" ::: "memory")
#define PG8_BAR __builtin_amdgcn_s_barrier()
#define PG8_SCHED __builtin_amdgcn_sched_barrier(0)
    Unit cur, nxt; int ui = 0;
    if (!S.next(0, cur)) return;
    f32x4 acc[2][2][4][2];
#pragma unroll
    for (int a = 0; a < 2; ++a)
#pragma unroll
        for (int b = 0; b < 2; ++b)
#pragma unroll
            for (int m = 0; m < 4; ++m)
#pragma unroll
                for (int n = 0; n < 2; ++n) acc[a][b][m][n] = (f32x4){0.f, 0.f, 0.f, 0.f};
    bf16x8 At[4][2], B0[2][2], B1[2][2];
    const char* cA = (const char*)g.A + (size_t)cur.pm * tstep + (size_t)cur.ko * 2; const char* cB = (const char*)g.Bt + (size_t)cur.pn * tstep + (size_t)cur.ko * 2;
    S.a_ready(cur);
    if constexpr (SP2) {
        PG8_STAGE(PG8_SB(0, 0), cB, voffB); PG8_STAGE(PG8_SB(0, 1), cB + hstep, voffB); PG8_STAGE(PG8_SA(0, 0), cA, voffA); PG8_STAGE(PG8_SA(0, 1), cA + hstep, voffA);
        if (wr == 1) PG8_BAR;
        PG8_WAIT_V(2); PG8_BAR;
        PG8_STAGE(PG8_SB(1, 0), cB + kstep, voffB); PG8_STAGE(PG8_SA(1, 0), cA + kstep, voffA); PG8_STAGE(PG8_SB(1, 1), cB + hstep + kstep, voffB);
        PG8_WAIT_V(6); PG8_BAR;
    } else {
        PG8_STAGE(PG8_SB(0, 0), cB, voffB); PG8_STAGE(PG8_SA(0, 0), cA, voffA); PG8_STAGE(PG8_SB(0, 1), cB + hstep, voffB); PG8_STAGE(PG8_SA(0, 1), cA + hstep, voffA);
        if (wr == 1) PG8_BAR;
        PG8_WAIT_V(4); PG8_BAR;
        PG8_STAGE(PG8_SB(1, 0), cB + kstep, voffB); PG8_STAGE(PG8_SA(1, 0), cA + kstep, voffA); PG8_STAGE(PG8_SB(1, 1), cB + hstep + kstep, voffB);
        PG8_WAIT_V(6); PG8_BAR;
    }
    for (;;) {
        const bool has_next = S.next(ui + 1, nxt);
        const char* nA = has_next ? (const char*)g.A + (size_t)nxt.pm * tstep + (size_t)nxt.ko * 2 : cA; const char* nB = has_next ? (const char*)g.Bt + (size_t)nxt.pn * tstep + (size_t)nxt.ko * 2 : cB;
        for (int t = 0; t < nt; t += 2) {
            const bool last = (t == nt - 2);
            const char* a1 = cA + (size_t)(t + 1) * kstep;
            const char* a2 = last ? nA : cA + (size_t)(t + 2) * kstep; const char* b2 = last ? nB : cB + (size_t)(t + 2) * kstep;
            const char* a3 = a2 + kstep; const char* b3 = b2 + kstep;
            if (last && has_next) S.a_ready(nxt);
            if constexpr (SP2) {
            PG8_LDB(B0, 0, 0); PG8_LDB(B1, 0, 1); PG8_SCHED; PG8_LDA(At, 0, 0); PG8_STAGE(PG8_SA(1, 1), a1 + hstep, voffA);
            PG8_WAIT_V(8); PG8_WAIT_L(0); PG8_BAR; PG8_MMA(0, 0, At, B0); PG8_MMA(0, 1, At, B1); PG8_BAR; PG8_SCHED;
            PG8_LDA(At, 0, 1); PG8_STAGE(PG8_SB(0, 0), b2, voffB); PG8_STAGE(PG8_SB(0, 1), b2 + hstep, voffB); PG8_STAGE(PG8_SA(0, 0), a2, voffA);
            PG8_WAIT_V(8); PG8_WAIT_L(0); PG8_BAR; PG8_MMA(1, 0, At, B0); PG8_MMA(1, 1, At, B1); PG8_BAR; PG8_SCHED;
            PG8_LDB(B0, 1, 0); PG8_LDB(B1, 1, 1); PG8_SCHED; PG8_LDA(At, 1, 0); PG8_STAGE(PG8_SA(0, 1), a2 + hstep, voffA);
            PG8_WAIT_V(8); PG8_WAIT_L(0); PG8_BAR; PG8_MMA(0, 0, At, B0); PG8_MMA(0, 1, At, B1); PG8_BAR; PG8_SCHED;
            PG8_LDA(At, 1, 1); PG8_STAGE(PG8_SB(1, 0), b3, voffB); PG8_STAGE(PG8_SB(1, 1), b3 + hstep, voffB); PG8_STAGE(PG8_SA(1, 0), a3, voffA);
            PG8_WAIT_V(8); PG8_WAIT_L(0); PG8_BAR; PG8_MMA(1, 0, At, B0); PG8_MMA(1, 1, At, B1); PG8_BAR; PG8_SCHED;
            } else {
            PG8_LDB(B0, 0, 0); PG8_SCHED; PG8_LDA(At, 0, 0); PG8_STAGE(PG8_SA(1, 1), a1 + hstep, voffA);
            PG8_WAIT_L(8); PG8_BAR; PG8_WAIT_L(0); PG8_MMA(0, 0, At, B0); PG8_BAR; PG8_SCHED;
            PG8_LDB(B1, 0, 1); PG8_STAGE(PG8_SB(0, 0), b2, voffB);
            PG8_BAR; PG8_WAIT_L(0); PG8_MMA(0, 1, At, B1); PG8_BAR;
            PG8_LDA(At, 0, 1); PG8_STAGE(PG8_SA(0, 0), a2, voffA);
            PG8_BAR; PG8_WAIT_L(0); PG8_MMA(1, 0, At, B0); PG8_BAR; PG8_SCHED;
            PG8_STAGE(PG8_SB(0, 1), b2 + hstep, voffB);
            PG8_WAIT_V(6); PG8_BAR; PG8_MMA(1, 1, At, B1); PG8_BAR;
            PG8_LDB(B0, 1, 0); PG8_SCHED; PG8_LDA(At, 1, 0); PG8_STAGE(PG8_SA(0, 1), a2 + hstep, voffA);
            PG8_WAIT_L(8); PG8_BAR; PG8_WAIT_L(0); PG8_MMA(0, 0, At, B0); PG8_BAR; PG8_SCHED;
            PG8_LDB(B1, 1, 1); PG8_STAGE(PG8_SB(1, 0), b3, voffB);
            PG8_BAR; PG8_WAIT_L(0); PG8_MMA(0, 1, At, B1); PG8_BAR;
            PG8_LDA(At, 1, 1); PG8_STAGE(PG8_SA(1, 0), a3, voffA);
            PG8_BAR; PG8_WAIT_L(0); PG8_MMA(1, 0, At, B0); PG8_BAR; PG8_SCHED;
            PG8_STAGE(PG8_SB(1, 1), b3 + hstep, voffB);
            PG8_WAIT_V(6); PG8_BAR; PG8_MMA(1, 1, At, B1); PG8_BAR;
            }
        }
        if constexpr (ALIGN_EPI) { if (wr == 0) PG8_BAR; }
        if constexpr (!Epi::AFTER_DRAIN) { E(acc, cur, wr, wc, fr, fq); S.done(cur); }
        if (!has_next) break;
#pragma unroll
        for (int a = 0; a < 2; ++a)
#pragma unroll
            for (int b = 0; b < 2; ++b)
#pragma unroll
                for (int m = 0; m < 4; ++m)
#pragma unroll
                    for (int n = 0; n < 2; ++n) acc[a][b][m][n] = (f32x4){0.f, 0.f, 0.f, 0.f};
        cur = nxt; cA = nA; cB = nB; ++ui;
        if constexpr (ALIGN_EPI) { if (wr == 1) PG8_BAR; }
    }
    PG8_WAIT_V(0);
    if constexpr (!ALIGN_EPI) { if (wr == 0) PG8_BAR; }
    PG8_BAR;
    if constexpr (Epi::AFTER_DRAIN) { E.fused(acc, cur, wr, wc, fr, fq, lds, wid, lane); S.done(cur); }
#undef PG8_SA
#undef PG8_SB
#undef PG8_STAGE
#undef PG8_LDA
#undef PG8_LDB
#undef PG8_MMA
#undef PG8_WAIT_V
#undef PG8_WAIT_L
#undef PG8_BAR
#undef PG8_SCHED
}
}

namespace mk {
using pg8::bf16_t; using pg8::f32x4; using pg8::u32x4; using pg8::bf16x8; using pg8::Unit;
typedef float f32x16 __attribute__((ext_vector_type(16)));
typedef float f32x2 __attribute__((ext_vector_type(2)));
typedef unsigned u32x2 __attribute__((ext_vector_type(2)));
typedef short s16x4 __attribute__((ext_vector_type(4)));
#define DI __device__ __forceinline__
#define LAS __attribute__((address_space(3)))
typedef LAS unsigned char* ldsp;

constexpr int M = 34816, MP = 32768, D = 1024, FF = 4096, NCHUNK = 544, NCHP = 512;
constexpr float EPS = 1e-6f;
constexpr float LAM_INIT = 0.35550906759096934f;
constexpr float QSCALE = 0.18033688011112042f;
constexpr float QA_SCALE = 0.08838834764831845f;
constexpr size_t O_Y = 0, O_SP = 35651584, O_KP = 35913728, O_VP = 52690944, O_SS = 69468160, O_KS = 73662464, O_VS = 74711040;
constexpr size_t MiB = 1u << 20;
constexpr size_t WS_CTL = 0, WS_WIN = 2 * MiB, WS_WOA = 10 * MiB, WS_WUP0 = 12 * MiB, WS_WDN0 = 20 * MiB, WS_WKVQ = 28 * MiB, WS_WOB = 32 * MiB, WS_WUP1 = 34 * MiB, WS_WDN1 = 42 * MiB;
constexpr size_t WS_COS = 50 * MiB, WS_SIN = 50 * MiB + 512 * 1024, WS_RINV = 51 * MiB, WS_DEC = 52 * MiB;
constexpr size_t WS_XB = 56 * MiB, WS_QB = 124 * MiB, WS_VB = 192 * MiB, WS_KB = 192 * MiB, WS_VB2 = 226 * MiB, WS_GATE = 260 * MiB, WS_MIXB = 260 * MiB;
constexpr size_t WS_G = 328 * MiB, WS_UT = 464 * MiB, WS_HB = 328 * MiB, WS_OB = 600 * MiB, WS_END = 720 * MiB;
constexpr int LDS_BYTES = 147456;

struct Params { const float* in[24]; float* out; unsigned char* ws; unsigned mask; unsigned pad; };
enum { I_XP = 0, I_XS, I_STATE, I_CK, I_CV, I_NMIXPRE, I_NMIXPOST, I_NMLPPRE, I_NMLPPOST, I_WUP, I_WDOWN, I_WIN, I_LB, I_GNORM, I_WOA, I_NKV, I_WKV, I_WQ, I_LQ1, I_LK1, I_LQ2, I_LK2, I_SUBLN, I_WOB };

DI unsigned pk2(float lo, float hi) { typedef __bf16 bf2 __attribute__((ext_vector_type(2))); f32x2 v = {lo, hi}; bf2 b = __builtin_convertvector(v, bf2); return __builtin_bit_cast(unsigned, b); }
DI float bflo(unsigned w) { return __uint_as_float(w << 16); }
DI float bfhi(unsigned w) { return __uint_as_float(w & 0xffff0000u); }
DI float bf2f(unsigned short u) { return __uint_as_float((unsigned)u << 16); }
DI unsigned short f2bf(float f) { return (unsigned short)(pk2(f, 0.f) & 0xffffu); }
DI float wave_sum(float v) {
#pragma unroll
    for (int o = 1; o < 64; o <<= 1) v += __shfl_xor(v, o);
    return v;
}
DI float fsigmoid(float x) { return __builtin_amdgcn_rcpf(1.f + __expf(-x)); }
DI float fsilu(float x) { return x * fsigmoid(x); }
DI int crow(int r, int hi) { return (r & 3) + 8 * (r >> 2) + 4 * hi; }
#define LDS_WAIT() asm volatile("s_waitcnt lgkmcnt(0)" ::: "memory")
DI f32x16 mfma32(bf16x8 a, bf16x8 b, f32x16 c) { return __builtin_amdgcn_mfma_f32_32x32x16_bf16(a, b, c, 0, 0, 0); }
DI f32x16 zero16() { f32x16 z;
#pragma unroll
    for (int i = 0; i < 16; ++i) z[i] = 0.f; return z; }
DI bf16x8 pack8(const f32x16& x, int s) {
    u32x4 p; p.x = pk2(x[8 * s + 0], x[8 * s + 1]); p.y = pk2(x[8 * s + 2], x[8 * s + 3]); p.z = pk2(x[8 * s + 4], x[8 * s + 5]); p.w = pk2(x[8 * s + 6], x[8 * s + 7]);
    return __builtin_bit_cast(bf16x8, p);
}
typedef short v4i16_t __attribute__((ext_vector_type(4)));
DI s16x4 vtr(LAS const unsigned char* p) { return __builtin_bit_cast(s16x4, __builtin_amdgcn_ds_read_tr16_b64_v4i16((LAS v4i16_t*)p)); }

struct EpiIn {
    static constexpr bool PERM = true, AFTER_DRAIN = false;
    unsigned char* ws; const float* lbl;
    DI void operator()(const f32x4 (&acc)[2][2][4][2], const Unit& u, int wr, int wc, int fr, int fq) const {
        const float* rinv = (const float*)(ws + WS_RINV); bf16_t* QB = (bf16_t*)(ws + WS_QB); bf16_t* G = (bf16_t*)(ws + WS_G); bf16_t* VB = (bf16_t*)(ws + WS_VB); bf16_t* GATE = (bf16_t*)(ws + WS_GATE);
        const int part = u.pn >> 2; const int cbase = (u.pn & 3) * 256 + wc * 32 + 8 * fq;
        float lb[2][8];
        if (part == 1) {
#pragma unroll
            for (int bj = 0; bj < 2; ++bj)
#pragma unroll
                for (int i = 0; i < 8; ++i) { const int c = cbase + bj * 128 + i; lb[bj][i] = fsigmoid(lbl[c] - lbl[1024 + c]); }
        }
#pragma unroll
        for (int ai = 0; ai < 2; ++ai)
#pragma unroll
            for (int m = 0; m < 4; ++m) {
                const int row = u.pm * 256 + ai * 128 + wr * 64 + m * 16 + fr; const float rs = rinv[row];
#pragma unroll
                for (int bj = 0; bj < 2; ++bj) {
                    const int c = cbase + bj * 128; float v[8];
#pragma unroll
                    for (int i = 0; i < 4; ++i) { v[i] = acc[ai][bj][m][0][i] * rs; v[4 + i] = acc[ai][bj][m][1][i] * rs; }
                    if (part == 1) {
                        f32x4 g0, g1;
#pragma unroll
                        for (int i = 0; i < 8; ++i) { const float f = lb[bj][i] + (1.f - lb[bj][i]) * fsigmoid(v[i]); const float g = __logf(f); if (i < 4) g0[i] = g; else g1[i - 4] = g; }
                        u32x4 w; w.x = pk2(g0[0], g0[1]); w.y = pk2(g0[2], g0[3]); w.z = pk2(g1[0], g1[1]); w.w = pk2(g1[2], g1[3]); *(u32x4*)(G + (size_t)row * 1024 + c) = w;
                    } else {
                        bf16_t* o = (part == 0 ? QB : (part == 2 ? VB : GATE)) + (size_t)row * 1024 + c;
                        if (part == 0) {
#pragma unroll
                            for (int i = 0; i < 8; ++i) v[i] = fsilu(v[i]) * QA_SCALE;
                        } else if (part == 3) {
#pragma unroll
                            for (int i = 0; i < 8; ++i) v[i] = fsilu(v[i]);
                        }
                        u32x4 w; w.x = pk2(v[0], v[1]); w.y = pk2(v[2], v[3]); w.z = pk2(v[4], v[5]); w.w = pk2(v[6], v[7]); *(u32x4*)o = w;
                    }
                }
            }
    }
};
struct EpiUp {
    static constexpr bool PERM = true, AFTER_DRAIN = false;
    unsigned char* ws;
    DI void operator()(const f32x4 (&acc)[2][2][4][2], const Unit& u, int wr, int wc, int fr, int fq) const {
        const float* rinv = (const float*)(ws + WS_RINV); bf16_t* HB = (bf16_t*)(ws + WS_HB);
        const int cbase = u.pn * 256 + wc * 32 + 8 * fq;
#pragma unroll
        for (int ai = 0; ai < 2; ++ai)
#pragma unroll
            for (int m = 0; m < 4; ++m) {
                const int row = u.pm * 256 + ai * 128 + wr * 64 + m * 16 + fr; const float rs = rinv[row];
#pragma unroll
                for (int bj = 0; bj < 2; ++bj) {
                    float v[8];
#pragma unroll
                    for (int i = 0; i < 4; ++i) { v[i] = acc[ai][bj][m][0][i] * rs; v[4 + i] = acc[ai][bj][m][1][i] * rs; }
#pragma unroll
                    for (int i = 0; i < 8; ++i) { const float t = fmaxf(v[i], 0.f); v[i] = t * t; }
                    u32x4 w; w.x = pk2(v[0], v[1]); w.y = pk2(v[2], v[3]); w.z = pk2(v[4], v[5]); w.w = pk2(v[6], v[7]);
                    *(u32x4*)(HB + (size_t)row * FF + cbase + bj * 128) = w;
                }
            }
    }
};
struct EpiMix {
    static constexpr bool PERM = true, AFTER_DRAIN = false;
    unsigned char* ws;
    DI void operator()(const f32x4 (&acc)[2][2][4][2], const Unit& u, int wr, int wc, int fr, int fq) const {
        bf16_t* MIXB = (bf16_t*)(ws + WS_MIXB);
        const int cbase = u.pn * 256 + wc * 32 + 8 * fq;
#pragma unroll
        for (int ai = 0; ai < 2; ++ai)
#pragma unroll
            for (int m = 0; m < 4; ++m) {
                const int row = u.pm * 256 + ai * 128 + wr * 64 + m * 16 + fr;
#pragma unroll
                for (int bj = 0; bj < 2; ++bj) {
                    const f32x4 a = acc[ai][bj][m][0], b = acc[ai][bj][m][1];
                    u32x4 w; w.x = pk2(a[0], a[1]); w.y = pk2(a[2], a[3]); w.z = pk2(b[0], b[1]); w.w = pk2(b[2], b[3]);
                    *(u32x4*)(MIXB + (size_t)row * 1024 + cbase + bj * 128) = w;
                }
            }
    }
};
struct EpiKvq {
    static constexpr bool PERM = true, AFTER_DRAIN = false;
    unsigned char* ws; float* out;
    DI void operator()(const f32x4 (&acc)[2][2][4][2], const Unit& u, int wr, int wc, int fr, int fq) const {
        const float* rinv = (const float*)(ws + WS_RINV); bf16_t* KB = (bf16_t*)(ws + WS_KB); bf16_t* VB2 = (bf16_t*)(ws + WS_VB2); bf16_t* QB2 = (bf16_t*)(ws + WS_QB); const float* COS = (const float*)(ws + WS_COS); const float* SIN = (const float*)(ws + WS_SIN);
        const int sec = u.pn < 2 ? 0 : (u.pn < 4 ? 1 : 2);
        const int cbase = u.pn * 256 + wc * 32 + 8 * fq;
        const bool rot = (sec != 1) && ((wc & 1) == 0);
#pragma unroll
        for (int ai = 0; ai < 2; ++ai)
#pragma unroll
            for (int m = 0; m < 4; ++m) {
                const int row = u.pm * 256 + ai * 128 + wr * 64 + m * 16 + fr; const float rs = rinv[row];
                const int pos = row < MP ? (row & 16383) : 4096 + ((row - MP) & 63);
                f32x4 c0, c1, s0, s1;
                if (rot) { c0 = *(const f32x4*)(COS + pos * 8); c1 = *(const f32x4*)(COS + pos * 8 + 4); s0 = *(const f32x4*)(SIN + pos * 8); s1 = *(const f32x4*)(SIN + pos * 8 + 4); }
#pragma unroll
                for (int bj = 0; bj < 2; ++bj) {
                    const int c = cbase + bj * 128; float v[8];
#pragma unroll
                    for (int i = 0; i < 4; ++i) { v[i] = acc[ai][bj][m][0][i] * rs; v[4 + i] = acc[ai][bj][m][1][i] * rs; }
                    if (rot) {
#pragma unroll
                        for (int i = 0; i < 8; ++i) {
                            const float pv = __shfl_xor(v[i], 16);
                            const float cs = i < 4 ? c0[i & 3] : c1[i & 3], sn = i < 4 ? s0[i & 3] : s1[i & 3];
                            const float r0 = v[i] * cs - pv * sn, r1 = v[i] * cs + pv * sn;
                            v[i] = fq == 0 ? r0 : (fq == 1 ? r1 : v[i]);
                        }
                    }
                    if (sec == 2) {
#pragma unroll
                        for (int i = 0; i < 8; ++i) v[i] *= QSCALE;
                        u32x4 w; w.x = pk2(v[0], v[1]); w.y = pk2(v[2], v[3]); w.z = pk2(v[4], v[5]); w.w = pk2(v[6], v[7]);
                        *(u32x4*)(QB2 + (size_t)row * 1024 + (c - 1024)) = w;
                    } else {
                        const int cc = sec == 0 ? c : c - 512;
                        float* o = out + (row < MP ? (sec == 0 ? O_KP : O_VP) + (size_t)row * 512 : (sec == 0 ? O_KS : O_VS) + (size_t)(row - MP) * 512) + cc;
                        *(f32x4*)o = (f32x4){v[0], v[1], v[2], v[3]}; *(f32x4*)(o + 4) = (f32x4){v[4], v[5], v[6], v[7]};
                        u32x4 w; w.x = pk2(v[0], v[1]); w.y = pk2(v[2], v[3]); w.z = pk2(v[4], v[5]); w.w = pk2(v[6], v[7]);
                        *(u32x4*)((sec == 0 ? KB : VB2) + (size_t)row * 512 + cc) = w;
                    }
                }
            }
    }
};

DI void transpose_item(const float* W, int K, int N, bf16_t* WT, int row_off, const float* gain, LAS float* scr, int item, int lane) {
    const int nblk = N / 32, kb = item / nblk, nb = item % nblk, k0 = 64 * kb, n0 = 32 * nb;
#pragma unroll 8
    for (int i = 0; i < 32; ++i) { const int kk = 2 * i + (lane >> 5); float w = W[(size_t)(k0 + kk) * N + n0 + (lane & 31)]; if (gain) w *= gain[k0 + kk]; scr[kk * 33 + (lane & 31)] = w; }
    LDS_WAIT(); asm volatile("" ::: "memory");
    const int c = lane & 7;
#pragma unroll
    for (int j = 0; j < 4; ++j) { const int n = (lane >> 3) + 8 * j; const LAS float* s = scr + (8 * c) * 33 + n;
        u32x4 o; o.x = pk2(s[0 * 33], s[1 * 33]); o.y = pk2(s[2 * 33], s[3 * 33]); o.z = pk2(s[4 * 33], s[5 * 33]); o.w = pk2(s[6 * 33], s[7 * 33]);
        *(u32x4*)(WT + (size_t)(row_off + n0 + n) * K + k0 + 8 * c) = o; }
    LDS_WAIT(); asm volatile("" ::: "memory");
}
DI void phase0(const Params& p, ldsp lds, int tid, int lane, int wave, unsigned full) {
    unsigned char* ws = p.ws;
    if (blockIdx.x == 0) { unsigned* ctl = (unsigned*)(ws + WS_CTL); for (int i = tid; i < 8192; i += 512) ctl[i] = 0u; }
    if (!full) return;
    const int gw = blockIdx.x * 8 + wave, NGW = gridDim.x * 8;
    LAS float* scr = (LAS float*)(lds + wave * 16384);
    constexpr int I_A = 16 * 128, I_B = 16 * 32, I_C = 64 * 32;
    constexpr int NITEMS = 4 * I_A + 4 * I_B + 2 * I_C - I_A;
    static_assert(NITEMS == 3 * I_A + 4 * I_B + 2 * I_C, "items");
    for (int it = gw; it < NITEMS; it += NGW) {
        int r = it;
        if (r < I_A) { transpose_item(p.in[I_WIN], 1024, 4096, (bf16_t*)(ws + WS_WIN), 0, p.in[I_NMIXPRE], scr, r, lane); continue; } r -= I_A;
        if (r < I_A) { transpose_item(p.in[I_WUP], 1024, 4096, (bf16_t*)(ws + WS_WUP0), 0, p.in[I_NMLPPRE], scr, r, lane); continue; } r -= I_A;
        if (r < I_A) { transpose_item(p.in[I_WUP] + (size_t)1024 * 4096, 1024, 4096, (bf16_t*)(ws + WS_WUP1), 0, p.in[I_NMLPPRE] + 1024, scr, r, lane); continue; } r -= I_A;
        if (r < I_C) { transpose_item(p.in[I_WDOWN], 4096, 1024, (bf16_t*)(ws + WS_WDN0), 0, nullptr, scr, r, lane); continue; } r -= I_C;
        if (r < I_C) { transpose_item(p.in[I_WDOWN] + (size_t)4096 * 1024, 4096, 1024, (bf16_t*)(ws + WS_WDN1), 0, nullptr, scr, r, lane); continue; } r -= I_C;
        if (r < I_B) { transpose_item(p.in[I_WOA], 1024, 1024, (bf16_t*)(ws + WS_WOA), 0, nullptr, scr, r, lane); continue; } r -= I_B;
        if (r < I_B) { transpose_item(p.in[I_WKV], 1024, 1024, (bf16_t*)(ws + WS_WKVQ), 0, p.in[I_NKV], scr, r, lane); continue; } r -= I_B;
        if (r < I_B) { transpose_item(p.in[I_WQ], 1024, 1024, (bf16_t*)(ws + WS_WKVQ), 1024, p.in[I_NMIXPRE] + 1024, scr, r, lane); continue; } r -= I_B;
        transpose_item(p.in[I_WOB], 1024, 1024, (bf16_t*)(ws + WS_WOB), 0, nullptr, scr, r, lane);
    }
    float* RINV = (float*)(ws + WS_RINV); bf16_t* XB = (bf16_t*)(ws + WS_XB);
    for (int m = gw; m < M; m += NGW) {
        const float* xr = m < MP ? p.in[I_XP] + (size_t)m * 1024 : p.in[I_XS] + (size_t)(m - MP) * 1024;
        f32x4 v[4]; float s = 0.f;
#pragma unroll
        for (int j = 0; j < 4; ++j) { v[j] = ((const f32x4*)xr)[lane + 64 * j]; s += (v[j].x * v[j].x + v[j].y * v[j].y) + (v[j].z * v[j].z + v[j].w * v[j].w); }
        s = wave_sum(s);
        if (lane == 0) RINV[m] = rsqrtf(s * (1.f / 1024.f) + EPS);
        u32x2* o = (u32x2*)(XB + (size_t)m * 1024) + lane;
#pragma unroll
        for (int j = 0; j < 4; ++j) { u32x2 w; w.x = pk2(v[j].x, v[j].y); w.y = pk2(v[j].z, v[j].w); o[64 * j] = w; }
    }
    float* COS = (float*)(ws + WS_COS); float* SIN = (float*)(ws + WS_SIN);
    for (int i = blockIdx.x * 512 + tid; i < 16384 * 8; i += gridDim.x * 512) {
        const int pos = i >> 3, d = i & 7;
        const double f = d == 0 ? 1.0 : d == 1 ? 0.19392274474868576 : d == 2 ? 0.03760603093086393 : d == 3 ? 0.007292664737217109 : d == 4 ? 0.001414213562373095 : d == 5 ? 0.0002742481756762073 : d == 6 ? 5.318295896944988e-05 : 1.031338537721246e-05;
        const float invf = (float)f;
        const float angf = (float)pos * invf;
        const double rev = (double)angf * 0.15915494309189535;
        const float fr = (float)(rev - __builtin_floor(rev));
        COS[i] = __builtin_amdgcn_cosf(fr); SIN[i] = __builtin_amdgcn_sinf(fr);
    }
}

template <bool FIRST, bool LAST> DI void thin_phase(const Params& p, const float* gpost, int lane, int wave) {
    unsigned char* ws = p.ws;
    const int gw = blockIdx.x * 8 + wave, NGW = gridDim.x * 8;
    float* RINV = (float*)(ws + WS_RINV); bf16_t* XB = (bf16_t*)(ws + WS_XB); const bf16_t* MIXB = (const bf16_t*)(ws + WS_MIXB); float* Y = p.out + O_Y;
    f32x4 gp[4];
#pragma unroll
    for (int j = 0; j < 4; ++j) gp[j] = ((const f32x4*)gpost)[lane + 64 * j];
    for (int m = gw; m < M; m += NGW) {
        const u32x2* mx = (const u32x2*)(MIXB + (size_t)m * 1024) + lane;
        f32x4 mv[4], hv[4]; float s = 0.f;
        if (FIRST) {
            const float* hr = m < MP ? p.in[I_XP] + (size_t)m * 1024 : p.in[I_XS] + (size_t)(m - MP) * 1024;
#pragma unroll
            for (int j = 0; j < 4; ++j) hv[j] = ((const f32x4*)hr)[lane + 64 * j];
        } else {
            const u32x2* hx = (const u32x2*)(XB + (size_t)m * 1024) + lane;
#pragma unroll
            for (int j = 0; j < 4; ++j) { const u32x2 w = hx[64 * j]; hv[j] = (f32x4){bflo(w.x), bfhi(w.x), bflo(w.y), bfhi(w.y)}; }
        }
        if (m < MP) {
#pragma unroll
            for (int j = 0; j < 4; ++j) { const u32x2 w = mx[64 * j]; mv[j] = (f32x4){bflo(w.x), bfhi(w.x), bflo(w.y), bfhi(w.y)}; }
        } else {
            const f32x4* pp = (const f32x4*)((const float*)(ws + WS_QB) + (size_t)(m - MP) * 1024) + lane;
#pragma unroll
            for (int j = 0; j < 4; ++j) { f32x4 a = pp[64 * j];
#pragma unroll
                for (int ks = 1; ks < 8; ++ks) a = a + pp[(size_t)ks * 2048 * 256 + 64 * j];
                mv[j] = a; }
        }
#pragma unroll
        for (int j = 0; j < 4; ++j) s += (mv[j].x * mv[j].x + mv[j].y * mv[j].y) + (mv[j].z * mv[j].z + mv[j].w * mv[j].w);
        s = wave_sum(s);
        const float r1 = rsqrtf(s * (1.f / 1024.f) + EPS);
#pragma unroll
        for (int j = 0; j < 4; ++j) hv[j] = hv[j] + mv[j] * r1 * gp[j];
        if (LAST) {
#pragma unroll
            for (int j = 0; j < 4; ++j) ((f32x4*)(Y + (size_t)m * 1024))[lane + 64 * j] = hv[j];
        } else {
            u32x2 w[4]; float s2 = 0.f;
#pragma unroll
            for (int j = 0; j < 4; ++j) { w[j].x = pk2(hv[j].x, hv[j].y); w[j].y = pk2(hv[j].z, hv[j].w);
                const float a = bflo(w[j].x), b = bfhi(w[j].x), c = bflo(w[j].y), d = bfhi(w[j].y); s2 += (a * a + b * b) + (c * c + d * d); }
            s2 = wave_sum(s2);
            if (lane == 0) RINV[m] = rsqrtf(s2 * (1.f / 1024.f) + EPS);
            u32x2* o = (u32x2*)(XB + (size_t)m * 1024) + lane;
#pragma unroll
            for (int j = 0; j < 4; ++j) o[64 * j] = w[j];
        }
    }
}

DI void hgrn_a(const Params& p, ldsp lds, int tid, int lane, int wave) {
    unsigned char* ws = p.ws;
    const bf16_t* G = (const bf16_t*)(ws + WS_G); const bf16_t* VB = (const bf16_t*)(ws + WS_VB); float* RU = (float*)(ws + WS_UT); float* RD = (float*)(ws + WS_DEC);
    LAS float* TOT = (LAS float*)(lds + 36864); LAS float* DECL = (LAS float*)(lds + 38912);
    const int d = tid & 127, tq = tid >> 7, r = lane & 31, h = lane >> 5, bm = wave >> 1;
    float gv[16]; unsigned short vv[16];
#define HA_LOAD(u_) do { const int cg_ = (u_) >> 3, hh_ = (u_) & 7; const size_t o_ = (size_t)(cg_ * 64 + 16 * tq) * 1024 + hh_ * 128 + d; \
        _Pragma("unroll") for (int i = 0; i < 16; ++i) { gv[i] = bf2f(G[o_ + (size_t)i * 1024]); vv[i] = VB[o_ + (size_t)i * 1024]; } } while (0)
    for (int run = blockIdx.x; run < 256; run += gridDim.x) {
        const int bh = run >> 4, rr = run & 15, hh = bh & 7, cg0 = (bh >> 3) * 256 + rr * 16;
        f32x16 S[2]; S[0] = zero16(); S[1] = zero16(); float bsum = 0.f;
        HA_LOAD(cg0 * 8 + hh);
        for (int ci = 0; ci < 16; ++ci) {
            const int cgi = cg0 + ci;
            float bl[16], kk[16];
            { float c = 0.f;
#pragma unroll
              for (int i = 0; i < 16; ++i) { kk[i] = 1.f - __expf(gv[i]); c += gv[i]; bl[i] = c; }
              TOT[tq * 128 + d] = c; }
            { u32x4 x0, x1;
              x0.x = vv[0] | ((unsigned)vv[1] << 16); x0.y = vv[2] | ((unsigned)vv[3] << 16); x0.z = vv[4] | ((unsigned)vv[5] << 16); x0.w = vv[6] | ((unsigned)vv[7] << 16);
              x1.x = vv[8] | ((unsigned)vv[9] << 16); x1.y = vv[10] | ((unsigned)vv[11] << 16); x1.z = vv[12] | ((unsigned)vv[13] << 16); x1.w = vv[14] | ((unsigned)vv[15] << 16);
              *(LAS u32x4*)(lds + 18432 + d * 144 + tq * 32) = x0; *(LAS u32x4*)(lds + 18432 + d * 144 + tq * 32 + 16) = x1; }
            if (ci + 1 < 16) HA_LOAD((cgi + 1) * 8 + hh);
            __syncthreads();
            float off = 0.f, blast = 0.f;
#pragma unroll
            for (int j = 0; j < 4; ++j) { const float t = TOT[j * 128 + d]; blast += t; if (j < tq) off += t; }
            { u32x4 w0, w1; float e[16];
#pragma unroll
              for (int i = 0; i < 16; ++i) e[i] = kk[i] * __expf(blast - (bl[i] + off));
              w0.x = pk2(e[0], e[1]); w0.y = pk2(e[2], e[3]); w0.z = pk2(e[4], e[5]); w0.w = pk2(e[6], e[7]); w1.x = pk2(e[8], e[9]); w1.y = pk2(e[10], e[11]); w1.z = pk2(e[12], e[13]); w1.w = pk2(e[14], e[15]);
              *(LAS u32x4*)(lds + d * 144 + tq * 32) = w0; *(LAS u32x4*)(lds + d * 144 + tq * 32 + 16) = w1; }
            if (tq == 0) { DECL[d] = __expf(blast); bsum += blast; }
            __syncthreads();
#pragma unroll
            for (int q = 0; q < 2; ++q) {
                const int bn = 2 * (wave & 1) + q; const float dc = DECL[32 * bn + r];
                f32x16 acc = S[q] * dc;
#pragma unroll
                for (int ks = 0; ks < 4; ++ks) {
                    const bf16x8 a = *(const LAS bf16x8*)(lds + 18432 + (32 * bm + r) * 144 + (16 * ks + 8 * h) * 2);
                    const bf16x8 b = *(const LAS bf16x8*)(lds + (32 * bn + r) * 144 + (16 * ks + 8 * h) * 2);
                    acc = mfma32(a, b, acc);
                }
                S[q] = acc;
            }
            __syncthreads();
        }
#pragma unroll
        for (int q = 0; q < 2; ++q) { const int bn = 2 * (wave & 1) + q; float* up = RU + ((size_t)run * 128) * 128 + 32 * bn + r;
#pragma unroll
            for (int reg = 0; reg < 16; ++reg) up[(size_t)(32 * bm + crow(reg, h)) * 128] = S[q][reg]; }
        if (tq == 0) RD[run * 128 + d] = __expf(bsum);
    }
#undef HA_LOAD
}
DI void hgrn_c(const Params& p, ldsp lds, int tid, int lane, int wave) {
    unsigned char* ws = p.ws;
    const bf16_t* G = (const bf16_t*)(ws + WS_G); const bf16_t* VB = (const bf16_t*)(ws + WS_VB); const bf16_t* QB = (const bf16_t*)(ws + WS_QB); const bf16_t* GATE = (const bf16_t*)(ws + WS_GATE);
    const float* RU = (const float*)(ws + WS_UT); const float* RD = (const float*)(ws + WS_DEC); bf16_t* OB = (bf16_t*)(ws + WS_OB); const float* gn = p.in[I_GNORM];
    LAS float* TOT = (LAS float*)(lds + 105472); LAS float* RED = (LAS float*)(lds + 107520); LAS float* DECL = (LAS float*)(lds + 126976);
    LAS bf16_t* QT = (LAS bf16_t*)(lds); LAS bf16_t* KT = (LAS bf16_t*)(lds + 17408); LAS bf16_t* QH = (LAS bf16_t*)(lds + 34816); LAS bf16_t* STl = (LAS bf16_t*)(lds + 70656);
    const int d = tid & 127, tq = tid >> 7, r = lane & 31, h = lane >> 5;
    const int dvb = wave & 3, tb = wave >> 2, bm = wave >> 1;
    float gv[16]; unsigned short vv[16], qq[16];
#define HC_LOAD(u_) do { const int cg_ = (u_) >> 3, hh_ = (u_) & 7; const size_t o_ = (size_t)(cg_ * 64 + 16 * tq) * 1024 + hh_ * 128 + d; \
        _Pragma("unroll") for (int i = 0; i < 16; ++i) { gv[i] = bf2f(G[o_ + (size_t)i * 1024]); vv[i] = VB[o_ + (size_t)i * 1024]; qq[i] = QB[o_ + (size_t)i * 1024]; } } while (0)
    for (int run = blockIdx.x; run < 512; run += gridDim.x) {
        const bool smp = run >= 256;
        int hh, cg0, nch, sidx, rr = 0;
        if (!smp) { const int bh = run >> 4; rr = run & 15; hh = bh & 7; cg0 = (bh >> 3) * 256 + rr * 16; nch = 16; sidx = bh; }
        else { const int bs = (run - 256) >> 3; hh = run & 7; cg0 = NCHP + bs; nch = 1; sidx = bs * 8 + hh; }
        HC_LOAD(cg0 * 8 + hh);
        f32x16 S[2];
        if (smp) {
#pragma unroll
            for (int q = 0; q < 2; ++q) { const int dk = 32 * (2 * (wave & 1) + q) + r; const float* sp = p.in[I_STATE] + ((size_t)sidx * 128 + dk) * 128;
#pragma unroll
                for (int g4 = 0; g4 < 4; ++g4) { const f32x4 v = *(const f32x4*)(sp + 32 * bm + 8 * g4 + 4 * h); S[q][4 * g4] = v.x; S[q][4 * g4 + 1] = v.y; S[q][4 * g4 + 2] = v.z; S[q][4 * g4 + 3] = v.w; } }
        } else {
            S[0] = zero16(); S[1] = zero16();
            for (int j = 0; j < rr; ++j) { const int rj = (run & ~15) + j;
#pragma unroll
                for (int q = 0; q < 2; ++q) { const int dk = 32 * (2 * (wave & 1) + q) + r; const float dc = RD[rj * 128 + dk]; const float* up = RU + ((size_t)rj * 128) * 128 + dk;
#pragma unroll
                    for (int reg = 0; reg < 16; ++reg) S[q][reg] = dc * S[q][reg] + up[(size_t)(32 * bm + crow(reg, h)) * 128]; } }
        }
        for (int ci = 0; ci < nch; ++ci) {
            const int cgi = cg0 + ci, row0 = cgi * 64;
            const size_t orow = (size_t)(row0 + 32 * tb + r) * 1024 + hh * 128;
            u32x2 gt[4];
#pragma unroll
            for (int g4 = 0; g4 < 4; ++g4) gt[g4] = *(const u32x2*)(GATE + orow + 32 * dvb + 8 * g4 + 4 * h);
            float bl[16];
            { float c = 0.f;
#pragma unroll
              for (int i = 0; i < 16; ++i) { c += gv[i]; bl[i] = c; }
              TOT[tq * 128 + d] = c; }
#pragma unroll
            for (int q = 0; q < 2; ++q) { const int dk = 32 * (2 * (wave & 1) + q) + r;
#pragma unroll
                for (int reg = 0; reg < 16; ++reg) STl[(32 * bm + crow(reg, h)) * 136 + dk] = f2bf(S[q][reg]); }
            __syncthreads();
            { float off = 0.f, blast = 0.f;
#pragma unroll
              for (int j = 0; j < 4; ++j) { const float t = TOT[j * 128 + d]; blast += t; if (j < tq) off += t; }
              const float bmid = TOT[d] + TOT[128 + d]; float e[16];
#pragma unroll
              for (int i = 0; i < 16; ++i) { const int t = 16 * tq + i; const float bt = bl[i] + off, kk = 1.f - __expf(gv[i]), qv = bf2f(qq[i]);
                  QT[t * 136 + d] = f2bf(qv * __expf(bt - bmid)); KT[t * 136 + d] = f2bf(kk * __expf(bmid - bt)); QH[t * 136 + d] = f2bf(qv * __expf(bt)); e[i] = kk * __expf(blast - bt); }
              u32x4 w0, w1;
              w0.x = pk2(e[0], e[1]); w0.y = pk2(e[2], e[3]); w0.z = pk2(e[4], e[5]); w0.w = pk2(e[6], e[7]); w1.x = pk2(e[8], e[9]); w1.y = pk2(e[10], e[11]); w1.z = pk2(e[12], e[13]); w1.w = pk2(e[14], e[15]);
              *(LAS u32x4*)(lds + 108544 + d * 144 + tq * 32) = w0; *(LAS u32x4*)(lds + 108544 + d * 144 + tq * 32 + 16) = w1;
              if (tq == 0) DECL[d] = __expf(blast);
              u32x4 x0, x1;
              x0.x = vv[0] | ((unsigned)vv[1] << 16); x0.y = vv[2] | ((unsigned)vv[3] << 16); x0.z = vv[4] | ((unsigned)vv[5] << 16); x0.w = vv[6] | ((unsigned)vv[7] << 16);
              x1.x = vv[8] | ((unsigned)vv[9] << 16); x1.y = vv[10] | ((unsigned)vv[11] << 16); x1.z = vv[12] | ((unsigned)vv[13] << 16); x1.w = vv[14] | ((unsigned)vv[15] << 16);
              *(LAS u32x4*)(lds + 52224 + d * 144 + tq * 32) = x0; *(LAS u32x4*)(lds + 52224 + d * 144 + tq * 32 + 16) = x1; }
            if (ci + 1 < nch) HC_LOAD((cgi + 1) * 8 + hh);
            __syncthreads();
            f32x16 o = zero16();
            for (int sb = 0; sb <= tb; ++sb) {
                f32x16 sc = zero16();
#pragma unroll
                for (int ks = 0; ks < 8; ++ks) {
                    const bf16x8 a = *(const LAS bf16x8*)(lds + 17408 + (32 * sb + r) * 272 + (16 * ks + 8 * h) * 2);
                    const bf16x8 b = *(const LAS bf16x8*)(lds + (32 * tb + r) * 272 + (16 * ks + 8 * h) * 2);
                    sc = mfma32(a, b, sc);
                }
                if (sb == tb) {
#pragma unroll
                    for (int reg = 0; reg < 16; ++reg) if (crow(reg, h) > r) sc[reg] = 0.f;
                }
#pragma unroll
                for (int s2 = 0; s2 < 2; ++s2) {
                    const int kb = 32 * sb + 16 * s2 + 4 * h;
                    const s16x4 lo = *(const LAS s16x4*)(lds + 52224 + (32 * dvb + r) * 144 + kb * 2);
                    const s16x4 hi = *(const LAS s16x4*)(lds + 52224 + (32 * dvb + r) * 144 + (kb + 8) * 2);
                    const bf16x8 a = (bf16x8){lo[0], lo[1], lo[2], lo[3], hi[0], hi[1], hi[2], hi[3]};
                    o = mfma32(a, pack8(sc, s2), o);
                }
            }
#pragma unroll
            for (int ks = 0; ks < 8; ++ks) {
                const bf16x8 a = *(const LAS bf16x8*)(lds + 70656 + (32 * dvb + r) * 272 + (16 * ks + 8 * h) * 2);
                const bf16x8 b = *(const LAS bf16x8*)(lds + 34816 + (32 * tb + r) * 272 + (16 * ks + 8 * h) * 2);
                o = mfma32(a, b, o);
            }
#pragma unroll
            for (int q = 0; q < 2; ++q) {
                const int bn = 2 * (wave & 1) + q; const float dc = DECL[32 * bn + r];
                f32x16 acc = S[q] * dc;
#pragma unroll
                for (int ks = 0; ks < 4; ++ks) {
                    const bf16x8 a = *(const LAS bf16x8*)(lds + 52224 + (32 * bm + r) * 144 + (16 * ks + 8 * h) * 2);
                    const bf16x8 b = *(const LAS bf16x8*)(lds + 108544 + (32 * bn + r) * 144 + (16 * ks + 8 * h) * 2);
                    acc = mfma32(a, b, acc);
                }
                S[q] = acc;
            }
            float ssq = 0.f;
#pragma unroll
            for (int reg = 0; reg < 16; ++reg) ssq += o[reg] * o[reg];
            ssq += __shfl_xor(ssq, 32);
            if (h == 0) RED[(tb * 4 + dvb) * 32 + r] = ssq;
            __syncthreads();
            const float tot = (RED[(tb * 4 + 0) * 32 + r] + RED[(tb * 4 + 1) * 32 + r]) + (RED[(tb * 4 + 2) * 32 + r] + RED[(tb * 4 + 3) * 32 + r]);
            const float rn = rsqrtf(tot * (1.f / 128.f) + EPS);
#pragma unroll
            for (int g4 = 0; g4 < 4; ++g4) { const int dv0 = 32 * dvb + 8 * g4 + 4 * h;
                const f32x4 gg = *(const f32x4*)(gn + dv0);
                u32x2 w; w.x = pk2(o[4 * g4] * rn * gg.x * bflo(gt[g4].x), o[4 * g4 + 1] * rn * gg.y * bfhi(gt[g4].x)); w.y = pk2(o[4 * g4 + 2] * rn * gg.z * bflo(gt[g4].y), o[4 * g4 + 3] * rn * gg.w * bfhi(gt[g4].y));
                *(u32x2*)(OB + orow + dv0) = w; }
            __syncthreads();
        }
        if (smp || rr == 15) {
            float* so = p.out + (smp ? O_SS : O_SP) + (size_t)sidx * 16384;
#pragma unroll
            for (int q = 0; q < 2; ++q) { const int dk = 32 * (2 * (wave & 1) + q) + r;
#pragma unroll
                for (int g4 = 0; g4 < 4; ++g4) *(f32x4*)(so + (size_t)dk * 128 + 32 * bm + 8 * g4 + 4 * h) = (f32x4){S[q][4 * g4], S[q][4 * g4 + 1], S[q][4 * g4 + 2], S[q][4 * g4 + 3]}; }
        }
    }
#undef HC_LOAD
}

constexpr int A_KB0 = 0, A_KBS = 17408, A_VB0 = 34816, A_VBS = 20480, A_ITEM = 76800;
DI void a_ld_bf(u32x4& a, u32x4& b, const bf16_t* T, int rowbase, int kvh, int tid) {
    const int k0 = tid >> 4, c8 = tid & 15;
    a = *(const u32x4*)(T + (size_t)(rowbase + k0) * 512 + kvh * 128 + c8 * 8); b = *(const u32x4*)(T + (size_t)(rowbase + 32 + k0) * 512 + kvh * 128 + c8 * 8);
}
DI void a_st_bf(ldsp buf, int stride, const u32x4& a, const u32x4& b, int tid) {
    const int k0 = tid >> 4, c8 = tid & 15;
    *(LAS u32x4*)(buf + k0 * stride + c8 * 16) = a; *(LAS u32x4*)(buf + (32 + k0) * stride + c8 * 16) = b;
}
DI void a_ld_f32(u32x4 (&st)[4], const float* C, int ctile, int tid) {
    const int k0 = tid >> 5, c4 = tid & 31;
#pragma unroll
    for (int i = 0; i < 4; ++i) st[i] = *(const u32x4*)(C + (size_t)(ctile * 64 + 16 * i + k0) * 512 + c4 * 4);
}
DI void a_st_f32(ldsp buf, int stride, const u32x4 (&st)[4], int tid) {
    const int k0 = tid >> 5, c4 = tid & 31;
#pragma unroll
    for (int i = 0; i < 4; ++i) { u32x2 w; w.x = pk2(__uint_as_float(st[i].x), __uint_as_float(st[i].y)); w.y = pk2(__uint_as_float(st[i].z), __uint_as_float(st[i].w));
        *(LAS u32x2*)(buf + (16 * i + k0) * stride + c4 * 8) = w; }
}
DI void a_qk(f32x16& p0, f32x16& p1, ldsp kb, int koff, const bf16x8 (&qr)[4]) {
    const f32x16 z = zero16();
#pragma unroll
    for (int d0 = 0; d0 < 4; ++d0) {
        const bf16x8 a0 = *(const LAS bf16x8*)(kb + koff + d0 * 32);
        const bf16x8 a1 = *(const LAS bf16x8*)(kb + koff + 32 * 272 + d0 * 32);
        p0 = mfma32(a0, qr[d0], d0 ? p0 : z); p1 = mfma32(a1, qr[d0], d0 ? p1 : z);
    }
}
DI float a_rowmax(const f32x16& p0, const f32x16& p1) {
    float a = fmaxf(fmaxf(p0[0], p0[1]), p1[0]), b = fmaxf(fmaxf(p0[2], p0[3]), p1[1]), c = fmaxf(fmaxf(p0[4], p0[5]), p1[2]), d = fmaxf(fmaxf(p0[6], p0[7]), p1[3]);
    a = fmaxf(fmaxf(a, p0[8]), p1[4]); b = fmaxf(fmaxf(b, p0[9]), p1[5]); c = fmaxf(fmaxf(c, p0[10]), p1[6]); d = fmaxf(fmaxf(d, p0[11]), p1[7]);
    a = fmaxf(fmaxf(a, p0[12]), p1[8]); b = fmaxf(fmaxf(b, p0[13]), p1[9]); c = fmaxf(fmaxf(c, p0[14]), p1[10]); d = fmaxf(fmaxf(d, p0[15]), p1[11]);
    a = fmaxf(fmaxf(a, p1[12]), p1[13]); b = fmaxf(fmaxf(b, p1[14]), p1[15]);
    float m = fmaxf(fmaxf(a, b), fmaxf(c, d));
    return fmaxf(m, __shfl_xor(m, 32));
}
struct AttnCtx { int tid, kvh, kbase, bs, nt; const float* ckp; const float* cvp; const bf16_t* KB; const bf16_t* VB2; int koff, tr_off, h; };
constexpr int F_KB0 = 0, F_KBS = 17408, F_VB0 = 34816, F_VBS = 20480;
DI void a_unit_fp(const Params& p, const AttnCtx& c, ldsp lds, f32x16 (&o)[4], const bf16x8 (&qr)[4], float& mrun, float& lrun, int mm, int lane) {
    const int tid = c.tid, kvh = c.kvh, kbase = c.kbase, bs = c.bs, ncache = 64, nt = 65, r = lane & 31, h = lane >> 5;
    const bf16_t* KB = c.KB; const bf16_t* VB2 = c.VB2;
    const int tr_off = (((lane & 15) >> 2)) * 320 + (16 * ((lane >> 4) & 1) + 4 * (lane & 3)) * 2;
    constexpr int A_KB0 = F_KB0, A_KBS = F_KBS, A_VB0 = F_VB0, A_VBS = F_VBS;
        mrun = -1e30f; lrun = 0.f;
        u32x4 st[8];
        const float* ckp = p.in[I_CK] + ((size_t)bs * 4096 * 4 + kvh) * 128; const float* cvp = p.in[I_CV] + ((size_t)bs * 4096 * 4 + kvh) * 128;
#define A_LOAD(t) do { if ((t) < ncache) { _Pragma("unroll") for (int i_ = 0; i_ < 4; ++i_) { const int key_ = tid >> 3, c4_ = (tid & 7) * 4 + i_; const size_t so_ = (size_t)((t) * 64 + key_) * 512 + c4_ * 4; \
                st[i_] = *(const u32x4*)(ckp + so_); st[4 + i_] = *(const u32x4*)(cvp + so_); } } \
            else { _Pragma("unroll") for (int i_ = 0; i_ < 2; ++i_) { const int key_ = tid >> 3, c8_ = (tid & 7) * 2 + i_; const size_t so_ = (size_t)(kbase + ((t) - ncache) * 64 + key_) * 512 + kvh * 128 + c8_ * 8; \
                st[i_] = *(const u32x4*)(KB + so_); st[2 + i_] = *(const u32x4*)(VB2 + so_); } } } while (0)
#define A_STORE(t) do { const int kb_ = A_KB0 + ((t) & 1) * A_KBS, vb_ = A_VB0 + ((t) & 1) * A_VBS; \
            if ((t) < ncache) { _Pragma("unroll") for (int i_ = 0; i_ < 4; ++i_) { const int key_ = tid >> 3, c4_ = (tid & 7) * 4 + i_; \
                u32x2 a_, b_; a_.x = pk2(__uint_as_float(st[i_].x), __uint_as_float(st[i_].y)); a_.y = pk2(__uint_as_float(st[i_].z), __uint_as_float(st[i_].w)); \
                b_.x = pk2(__uint_as_float(st[4 + i_].x), __uint_as_float(st[4 + i_].y)); b_.y = pk2(__uint_as_float(st[4 + i_].z), __uint_as_float(st[4 + i_].w)); \
                *(LAS u32x2*)(lds + kb_ + key_ * 272 + c4_ * 8) = a_; *(LAS u32x2*)(lds + vb_ + key_ * 320 + c4_ * 8) = b_; } } \
            else { _Pragma("unroll") for (int i_ = 0; i_ < 2; ++i_) { const int key_ = tid >> 3, c8_ = (tid & 7) * 2 + i_; \
                *(LAS u32x4*)(lds + kb_ + key_ * 272 + c8_ * 16) = st[i_]; *(LAS u32x4*)(lds + vb_ + key_ * 320 + c8_ * 16) = st[2 + i_]; } } } while (0)
        A_LOAD(0);
        A_STORE(0);
        __syncthreads();
        for (int t = 0; t < nt; ++t) {
            if (t + 1 < nt) A_LOAD(t + 1);
            const int kb = A_KB0 + (t & 1) * A_KBS, vb = A_VB0 + (t & 1) * A_VBS;
            f32x16 p0 = zero16(), p1 = zero16();
#pragma unroll
            for (int d0 = 0; d0 < 4; ++d0) {
                const bf16x8 a0 = *(const LAS bf16x8*)(lds + kb + r * 272 + (mm * 64 + 16 * d0 + 8 * h) * 2);
                const bf16x8 a1 = *(const LAS bf16x8*)(lds + kb + (32 + r) * 272 + (mm * 64 + 16 * d0 + 8 * h) * 2);
                p0 = mfma32(a0, qr[d0], p0); p1 = mfma32(a1, qr[d0], p1);
            }
            float mx = fmaxf(p0[0], p1[0]);
#pragma unroll
            for (int i = 1; i < 16; ++i) mx = fmaxf(mx, fmaxf(p0[i], p1[i]));
            mx = fmaxf(mx, __shfl_xor(mx, 32));
            if (__any(mx > mrun + 8.f)) {
                const float mn = fmaxf(mrun, mx), al = __builtin_amdgcn_exp2f(mrun - mn);
                lrun *= al; mrun = mn;
#pragma unroll
                for (int i = 0; i < 4; ++i)
#pragma unroll
                    for (int j = 0; j < 16; ++j) o[i][j] *= al;
            }
            float ls = 0.f;
#pragma unroll
            for (int i = 0; i < 16; ++i) { p0[i] = __builtin_amdgcn_exp2f(p0[i] - mrun); p1[i] = __builtin_amdgcn_exp2f(p1[i] - mrun); ls += p0[i] + p1[i]; }
            lrun += ls;
            bf16x8 pk[4]; pk[0] = pack8(p0, 0); pk[1] = pack8(p0, 1); pk[2] = pack8(p1, 0); pk[3] = pack8(p1, 1);
#pragma unroll
            for (int s = 0; s < 4; ++s) {
                const int keyb = 32 * (s >> 1) + 16 * (s & 1) + 4 * h;
#pragma unroll
                for (int db = 0; db < 4; ++db) {
                    const s16x4 lo = vtr(lds + vb + keyb * 320 + db * 64 + tr_off);
                    const s16x4 hi = vtr(lds + vb + (keyb + 8) * 320 + db * 64 + tr_off);
                    const bf16x8 a = (bf16x8){lo[0], lo[1], lo[2], lo[3], hi[0], hi[1], hi[2], hi[3]};
                    o[db] = mfma32(a, pk[s], o[db]);
                }
            }
            if (t + 1 < nt) A_STORE(t + 1);
            __syncthreads();
        }
#undef A_LOAD
#undef A_STORE
}
constexpr int B_K0 = 0, B_V0 = 32768, B_TS = 16384;
DI void a_dma_tile(ldsp dst, const bf16_t* T, int rowbase, int kvh, int wave, int lane, bool isV) {
#pragma unroll
    for (int i = 0; i < 2; ++i) {
        const int j = wave + 8 * i, row = 4 * j + (lane >> 4), pc = lane & 15, cch = isV ? (pc ^ ((row & 3) << 2)) : (pc ^ (row & 15));
        __builtin_amdgcn_global_load_lds((const unsigned*)(T + (size_t)(rowbase + row) * 512 + kvh * 128 + cch * 8), (LAS unsigned*)(dst + j * 1024), 16, 0, 0);
    }
}
DI void b_qk(f32x16& p0, f32x16& p1, ldsp kb, int koff, const bf16x8 (&qr)[4], const f32x16& z) {
#pragma unroll
    for (int d0 = 0; d0 < 4; ++d0) {
        const bf16x8 a0 = *(const LAS bf16x8*)(kb + (koff ^ (d0 * 32)));
        const bf16x8 a1 = *(const LAS bf16x8*)(kb + (koff ^ (d0 * 32)) + 8192);
        p0 = mfma32(a0, qr[d0], d0 ? p0 : z); p1 = mfma32(a1, qr[d0], d0 ? p1 : z);
    }
}
#define SB() __builtin_amdgcn_sched_barrier(0)
DI void b_vfrag(s16x4 (&f)[8], ldsp vb, const int (&trb)[4], int s) {
    const int kimm = (32 * (s >> 1) + 16 * (s & 1)) * 256;
#pragma unroll
    for (int db = 0; db < 4; ++db) { f[2 * db] = vtr(vb + trb[db] + kimm); f[2 * db + 1] = vtr(vb + trb[db] + kimm + 8 * 256); }
}
DI void b_pv(f32x16 (&o)[4], const s16x4 (&f)[8], bf16x8 pk) {
#pragma unroll
    for (int db = 0; db < 4; ++db) { const s16x4 lo = f[2 * db], hi = f[2 * db + 1];
        o[db] = mfma32((bf16x8){lo[0], lo[1], lo[2], lo[3], hi[0], hi[1], hi[2], hi[3]}, pk, o[db]); }
}
DI void b_step(const AttnCtx& c, ldsp lds, int wave, int lane, int t, f32x16& S0, f32x16& S1, f32x16& N0, f32x16& N1, f32x16 (&o)[4], const bf16x8 (&qr)[4], const int (&trb)[4], f32x16& negm, float& lrun) {
    const int tK = min(t + 2, c.nt - 1), tV = min(t + 1, c.nt - 1);
    const bool hasN = t + 1 < c.nt;
    a_dma_tile(lds + B_K0 + (t & 1) * B_TS, c.KB, c.kbase + tK * 64, c.kvh, wave, lane, false);
    a_dma_tile(lds + B_V0 + ((t + 1) & 1) * B_TS, c.VB2, c.kbase + tV * 64, c.kvh, wave, lane, true);
    const ldsp kb = lds + B_K0 + ((t + 1) & 1) * B_TS, vb = lds + B_V0 + (t & 1) * B_TS;
    bf16x8 ka[4], kc[4]; s16x4 f0[8], f1[8]; bf16x8 pk0, pk1, pk2, pk3; float ls = 0.f;
    ka[0] = *(const LAS bf16x8*)(kb + c.koff); ka[1] = *(const LAS bf16x8*)(kb + c.koff + 8192); ka[2] = *(const LAS bf16x8*)(kb + (c.koff ^ 32)); ka[3] = *(const LAS bf16x8*)(kb + (c.koff ^ 32) + 8192);
    SB();
    N0 = mfma32(ka[0], qr[0], negm); N1 = mfma32(ka[1], qr[0], negm); N0 = mfma32(ka[2], qr[1], N0); N1 = mfma32(ka[3], qr[1], N1);
    kc[0] = *(const LAS bf16x8*)(kb + (c.koff ^ 64)); kc[1] = *(const LAS bf16x8*)(kb + (c.koff ^ 64) + 8192); kc[2] = *(const LAS bf16x8*)(kb + (c.koff ^ 96)); kc[3] = *(const LAS bf16x8*)(kb + (c.koff ^ 96) + 8192);
#pragma unroll
    for (int i = 0; i < 16; ++i) { S0[i] = __builtin_amdgcn_exp2f(S0[i]); ls += S0[i]; }
    SB();
    N0 = mfma32(kc[0], qr[2], N0); N1 = mfma32(kc[1], qr[2], N1); N0 = mfma32(kc[2], qr[3], N0); N1 = mfma32(kc[3], qr[3], N1);
    b_vfrag(f0, vb, trb, 0);
    pk0 = pack8(S0, 0); pk1 = pack8(S0, 1);
#pragma unroll
    for (int i = 0; i < 8; ++i) { S1[i] = __builtin_amdgcn_exp2f(S1[i]); ls += S1[i]; }
    SB();
    __builtin_amdgcn_s_setprio(1);
    b_pv(o, f0, pk0);
    b_vfrag(f1, vb, trb, 1);
#pragma unroll
    for (int i = 8; i < 16; ++i) { S1[i] = __builtin_amdgcn_exp2f(S1[i]); ls += S1[i]; }
    SB();
    b_pv(o, f1, pk1);
    b_vfrag(f0, vb, trb, 2);
    pk2 = pack8(S1, 0); pk3 = pack8(S1, 1);
    lrun += ls;
    SB();
    b_pv(o, f0, pk2);
    b_vfrag(f1, vb, trb, 3);
    float mx = a_rowmax(N0, N1); mx = hasN ? mx : -1e30f;
    SB();
    b_pv(o, f1, pk3);
    __builtin_amdgcn_s_setprio(0);
    SB();
    if (__any(mx > 8.f)) {
        const float dl = fmaxf(mx, 0.f), al = __builtin_amdgcn_exp2f(-dl);
        lrun *= al;
#pragma unroll
        for (int i = 0; i < 4; ++i)
#pragma unroll
            for (int j = 0; j < 16; ++j) o[i][j] *= al;
#pragma unroll
        for (int j = 0; j < 16; ++j) { N0[j] -= dl; N1[j] -= dl; negm[j] -= dl; }
    }
    __syncthreads();
}
DI void a_unit_bf(const AttnCtx& c, ldsp lds, int wave, int lane, int mm, f32x16 (&o)[4], const bf16x8 (&qr)[4], float& mrun, float& lrun) {
    const int r = lane & 31, h = lane >> 5, q = (lane & 15) >> 2, pp = lane & 3, g16 = (lane >> 4) & 1;
    int trb[4];
#pragma unroll
    for (int db = 0; db < 4; ++db) trb[db] = (4 * h + q) * 256 + (4 * (db ^ q) + 2 * g16 + (pp >> 1)) * 16 + 8 * (pp & 1);
    AttnCtx cc = c; cc.koff = r * 256 + (((8 * mm + h) ^ (r & 15)) * 16);
    a_dma_tile(lds + B_K0, c.KB, c.kbase, c.kvh, wave, lane, false);
    a_dma_tile(lds + B_V0, c.VB2, c.kbase, c.kvh, wave, lane, true);
    a_dma_tile(lds + B_K0 + B_TS, c.KB, c.kbase + min(1, c.nt - 1) * 64, c.kvh, wave, lane, false);
    __syncthreads();
    f32x16 A0, A1, B0, B1, negm;
    b_qk(A0, A1, lds + B_K0, cc.koff, qr, zero16());
    mrun = a_rowmax(A0, A1); lrun = 0.f;
#pragma unroll
    for (int j = 0; j < 16; ++j) { A0[j] -= mrun; A1[j] -= mrun; negm[j] = -mrun; }
    for (int t = 0; t < c.nt; t += 2) {
        b_step(cc, lds, wave, lane, t, A0, A1, B0, B1, o, qr, trb, negm, lrun);
        if (t + 1 < c.nt) b_step(cc, lds, wave, lane, t + 1, B0, B1, A0, A1, o, qr, trb, negm, lrun);
    }
}
DI void attn_phase(const Params& p, ldsp lds, int tid0, int lane0, int wave) {
    unsigned char* ws = p.ws;
    const bf16_t* QB2 = (const bf16_t*)(ws + WS_QB); bf16_t* OB = (bf16_t*)(ws + WS_OB);
    unsigned* qhead = (unsigned*)(ws + WS_CTL);
    const int th = wave & 1, g = (wave >> 1) & 1, mm = wave >> 2;
    const int x = blockIdx.x & 7;
    float lam;
    { const float a = p.in[I_LQ1][lane0] * p.in[I_LK1][lane0], b = p.in[I_LQ2][lane0] * p.in[I_LK2][lane0]; lam = __expf(wave_sum(a)) - __expf(wave_sum(b)) + LAM_INIT; }
    for (;;) {
        int lane = lane0; asm volatile("" : "+v"(lane));
        const int tid = (wave << 6) | lane, r = lane & 31, h = lane >> 5;
        AttnCtx c; c.tid = tid; c.h = h; c.KB = (const bf16_t*)(ws + WS_KB); c.VB2 = (const bf16_t*)(ws + WS_VB2); c.koff = 0; c.tr_off = 0;
        if (tid == 0) *(LAS unsigned*)(lds + A_ITEM) = __hip_atomic_fetch_add(qhead + x * 64, 1u, __ATOMIC_RELAXED, __HIP_MEMORY_SCOPE_AGENT);
        __syncthreads();
        const int item = (int)*(LAS unsigned*)(lds + A_ITEM);
        if (item >= 16 + 256) break;
        int qrow0; bool fp;
        if (item < 16) { c.bs = x * 4 + (item >> 2); c.kvh = item & 3; qrow0 = MP + c.bs * 64; c.kbase = qrow0; fp = true; c.nt = 65; }
        else { const int b = x >> 2, qc = 255 - (item - 16); c.bs = 0; c.kvh = x & 3; qrow0 = b * 16384 + qc * 64; c.kbase = b * 16384; fp = false; c.nt = qc + 1; }
        c.ckp = p.in[I_CK] + ((size_t)c.bs * 4096 * 4 + c.kvh) * 128; c.cvp = p.in[I_CV] + ((size_t)c.bs * 4096 * 4 + c.kvh) * 128;
        const int hq = c.kvh * 2 + g;
        bf16x8 qr[4];
        { const bf16_t* qp = QB2 + (size_t)(qrow0 + 32 * th + r) * 1024 + hq * 128 + mm * 64 + 8 * h;
#pragma unroll
          for (int d0 = 0; d0 < 4; ++d0) qr[d0] = *(const bf16x8*)(qp + 16 * d0); }
        f32x16 o[4];
#pragma unroll
        for (int i = 0; i < 4; ++i) o[i] = zero16();
        float mrun, lrun;
        if (fp) a_unit_fp(p, c, lds, o, qr, mrun, lrun, mm, lane); else a_unit_bf(c, lds, wave, lane, mm, o, qr, mrun, lrun);
        lrun += __shfl_xor(lrun, 32);
        const float inv = __builtin_amdgcn_rcpf(lrun);
        LAS float* cmb = (LAS float*)(lds) + (size_t)(g * 2 + th) * 4096 + lane;
        if (mm == 1) {
            const float sc = lam * inv;
#pragma unroll
            for (int i = 0; i < 4; ++i)
#pragma unroll
                for (int j = 0; j < 16; ++j) cmb[(i * 16 + j) * 64] = o[i][j] * sc;
        }
        __syncthreads();
        if (mm == 0) {
            float ssq = 0.f;
#pragma unroll
            for (int i = 0; i < 4; ++i)
#pragma unroll
                for (int j = 0; j < 16; ++j) { const float v = o[i][j] * inv - cmb[(i * 16 + j) * 64]; o[i][j] = v; ssq += v * v; }
            ssq += __shfl_xor(ssq, 32);
            const float rn = rsqrtf(ssq * (1.f / 128.f) + EPS) * (1.f - LAM_INIT);
            bf16_t* op = OB + (size_t)(qrow0 + 32 * th + r) * 1024 + hq * 128;
#pragma unroll
            for (int i = 0; i < 4; ++i)
#pragma unroll
                for (int g4 = 0; g4 < 4; ++g4) { const int dv0 = 32 * i + 8 * g4 + 4 * h; const f32x4 gg = *(const f32x4*)(p.in[I_SUBLN] + dv0);
                    u32x2 w; w.x = pk2(o[i][4 * g4] * rn * gg.x, o[i][4 * g4 + 1] * rn * gg.y); w.y = pk2(o[i][4 * g4 + 2] * rn * gg.z, o[i][4 * g4 + 3] * rn * gg.w);
                    *(u32x2*)(op + dv0) = w; }
        }
        __syncthreads();
    }
}

#define XB_TMO      128
#define XB_XCNT(j)  (256  + 64 * (j))
#define XB_XSUB(j)  (1280 + 64 * (j))
#define XB_XGEN(j)  (2304 + 64 * (j))
#define XB_TOP      3328
#define XB_TOPGEN   3392
#define XCD_BAR_WORDS 3456
#define XB_SPIN_CAP (1u << 18)

__device__ __forceinline__ unsigned xb_ld(unsigned* p)              { return __hip_atomic_load(p, __ATOMIC_RELAXED, __HIP_MEMORY_SCOPE_AGENT); }
__device__ __forceinline__ unsigned xb_add(unsigned* p, unsigned v) { return __hip_atomic_fetch_add(p, v, __ATOMIC_RELAXED, __HIP_MEMORY_SCOPE_AGENT); }
__device__ __forceinline__ unsigned xb_xcc_id() { return (unsigned)__builtin_amdgcn_s_getreg((3 << 11) | 20) & 0xFu; }
#define XB_SPIN(cond, bar) do { unsigned _sp = 0; while (cond) { __builtin_amdgcn_s_sleep(1); \
    if ((++_sp & 255u) == 0u) { if (xb_ld(&(bar)[XB_TMO])) break; if (_sp > XB_SPIN_CAP) { atomicAdd(&(bar)[XB_TMO], 1u); break; } } } } while (0)

struct XcdBarrier {
    unsigned* bar; unsigned x;
    volatile LAS unsigned* st;
};

__device__ __forceinline__ XcdBarrier xcd_barrier_post(unsigned* bar, volatile LAS unsigned* st) {
    XcdBarrier b; b.bar = bar; b.x = xb_xcc_id(); b.st = st;
    if (threadIdx.x == 0) (void)xb_add(&bar[XB_XCNT(b.x)], 1u);
    return b;
}
__device__ __forceinline__ void xcd_barrier_complete(unsigned* bar, unsigned x, unsigned& nloc, unsigned& nx) {
    const unsigned G = gridDim.x * gridDim.y * gridDim.z;
    unsigned sum, cnt, mine, sp = 0u;
    for (;;) {
        sum = 0u; cnt = 0u; mine = 0u;
#pragma unroll
        for (unsigned j = 0; j < 16; ++j) { const unsigned c = xb_ld(&bar[XB_XCNT(j)]); sum += c; cnt += (c > 0u) ? 1u : 0u; mine = (j == x) ? c : mine; }
        if (sum == G) break;
        __builtin_amdgcn_s_sleep(1);
        if ((++sp & 255u) == 0u) { if (xb_ld(&bar[XB_TMO])) break; if (sp > XB_SPIN_CAP) { atomicAdd(&bar[XB_TMO], 1u); break; } }
    }
    nloc = mine > 0u ? mine : 1u; nx = cnt > 0u ? cnt : 1u;
}

__device__ __forceinline__ void xcd_barrier(const XcdBarrier& b) {
    asm volatile("s_waitcnt vmcnt(0)" ::: "memory");
    __syncthreads();
    if (threadIdx.x == 0) {
        unsigned* bar = b.bar;
        __builtin_amdgcn_s_waitcnt(0);
        unsigned nloc = b.st[0], nx = b.st[1];
        if (nloc == 0u) { xcd_barrier_complete(bar, b.x, nloc, nx); b.st[0] = nloc; b.st[1] = nx; }
        const unsigned old = xb_add(&bar[XB_XSUB(b.x)], 1u);
        const unsigned gen = old / nloc;
        if (old + 1u == (gen + 1u) * nloc) {
            __builtin_amdgcn_fence(__ATOMIC_RELEASE, "agent");
            asm volatile("s_waitcnt vmcnt(0)" ::: "memory");
            const unsigned og = xb_add(&bar[XB_TOP], 1u);
            const unsigned tg = og / nx;
            if (og + 1u == (tg + 1u) * nx) xb_add(&bar[XB_TOPGEN], 1u);
            else XB_SPIN(xb_ld(&bar[XB_TOPGEN]) == tg, bar);
            __builtin_amdgcn_fence(__ATOMIC_ACQUIRE, "agent");
            xb_add(&bar[XB_XGEN(b.x)], 1u);
            asm volatile("s_waitcnt vmcnt(0)" ::: "memory");
        } else {
            XB_SPIN(xb_ld(&bar[XB_XGEN(b.x)]) == gen, bar);
            __builtin_amdgcn_fence(__ATOMIC_ACQUIRE, "agent");
            asm volatile("s_waitcnt vmcnt(0)" ::: "memory");
        }
    }
    __syncthreads();
}

struct SplitSched {
    int G, c;
    DI bool next(int i, Unit& u) const { const int L = i * G + c; if (L >= 256) return false; u.ko = (L & 7); u.pn = (L >> 3) & 3; u.pm = 128 + (L >> 5); return true; }
    DI void a_ready(const Unit&) const {}
    DI void done(const Unit&) const {}
};
struct EpiPart {
    static constexpr bool PERM = true, AFTER_DRAIN = false;
    float* PART; int kslice;
    DI void operator()(const f32x4 (&acc)[2][2][4][2], const Unit& u, int wr, int wc, int fr, int fq) const {
        const int cbase = u.pn * 256 + wc * 32 + 8 * fq; float* base = PART + (size_t)(u.ko / kslice) * 2048 * 1024;
#pragma unroll
        for (int ai = 0; ai < 2; ++ai)
#pragma unroll
            for (int m = 0; m < 4; ++m) {
                const int row = (u.pm - 128) * 256 + ai * 128 + wr * 64 + m * 16 + fr;
#pragma unroll
                for (int bj = 0; bj < 2; ++bj) { float* o = base + (size_t)row * 1024 + cbase + bj * 128; *(f32x4*)o = acc[ai][bj][m][0]; *(f32x4*)(o + 4) = acc[ai][bj][m][1]; }
            }
    }
};
struct SplitSchedK {
    int G, c, kslice;
    DI bool next(int i, Unit& u) const { const int L = i * G + c; if (L >= 256) return false; u.ko = (L & 7) * kslice; u.pn = (L >> 3) & 3; u.pm = 128 + (L >> 5); return true; }
    DI void a_ready(const Unit&) const {}
    DI void done(const Unit&) const {}
};
DI void run_gemm_mix(ldsp lds, unsigned char* ws, const bf16_t* A, const bf16_t* Bt, int K) {
    { pg8::Gemm g{A, Bt, MP, 1024, K, K}; pg8::StaticOrder S; S.init(MP, 1024, (int)gridDim.x, (int)blockIdx.x); EpiMix E{ws};
      pg8::gemm_phase<EpiMix, pg8::StaticOrder, true, true>(lds, g, S, E); }
    { pg8::Gemm g{A, Bt, M, 1024, K / 8, K}; SplitSchedK S{(int)gridDim.x, (int)blockIdx.x, K / 8}; EpiPart E{(float*)(ws + WS_QB), K / 8};
      pg8::gemm_phase<EpiPart, SplitSchedK, false, true>(lds, g, S, E); }
}
template <class Epi> DI void run_gemm(ldsp lds, const bf16_t* A, const bf16_t* Bt, int N, int K, const Epi& E) {
    pg8::Gemm g{A, Bt, M, N, K, K}; pg8::StaticOrder S; S.init(M, N, (int)gridDim.x, (int)blockIdx.x);
    pg8::gemm_phase<Epi, pg8::StaticOrder, true, true>(lds, g, S, E);
}
#ifndef MK_LAST_PHASE
#define MK_LAST_PHASE 99
#endif
__global__ void __launch_bounds__(512, 2) yoco_fwd(Params p) {
    extern __shared__ __attribute__((aligned(16))) unsigned char lds_raw[];
    cg::grid_group grid = cg::this_grid();
    ldsp lds = (ldsp)lds_raw;
    const int tid = threadIdx.x, lane = tid & 63, wave = __builtin_amdgcn_readfirstlane(tid >> 6);
    unsigned char* ws = p.ws;
    float* RINV = (float*)(ws + WS_RINV); bf16_t* XB = (bf16_t*)(ws + WS_XB); bf16_t* MIXB = (bf16_t*)(ws + WS_MIXB); bf16_t* OB = (bf16_t*)(ws + WS_OB); bf16_t* HB = (bf16_t*)(ws + WS_HB);
#define SEAM(k) xcd_barrier(bar)
#define PH(k) ((p.mask >> (k)) & 1u)
    volatile LAS unsigned* xst = (volatile LAS unsigned*)(lds + 147200);
    if (tid < 2) xst[tid] = 0u;
    phase0(p, lds, tid, lane, wave, PH(0));
    grid.sync();
    XcdBarrier bar = xcd_barrier_post((unsigned*)(ws + WS_CTL) + 4096, xst);
    if (PH(1)) { EpiIn E{ws, p.in[I_LB]}; run_gemm(lds, XB, (const bf16_t*)(ws + WS_WIN), 4096, 1024, E); }
    SEAM(1);
    if (PH(2)) hgrn_a(p, lds, tid, lane, wave);
    SEAM(2);
    if (PH(4)) hgrn_c(p, lds, tid, lane, wave);
    SEAM(4);
    if (PH(5)) run_gemm_mix(lds, ws, OB, (const bf16_t*)(ws + WS_WOA), 1024);
    SEAM(5);
    if (PH(6)) thin_phase<false, false>(p, p.in[I_NMIXPOST], lane, wave);
    SEAM(6);
    if (PH(7)) { EpiUp E{ws}; run_gemm(lds, XB, (const bf16_t*)(ws + WS_WUP0), 4096, 1024, E); }
    SEAM(7);
    if (PH(8)) run_gemm_mix(lds, ws, HB, (const bf16_t*)(ws + WS_WDN0), 4096);
    SEAM(8);
    if (PH(9)) thin_phase<false, false>(p, p.in[I_NMLPPOST], lane, wave);
    SEAM(9);
    if (PH(10)) { EpiKvq E{ws, p.out}; run_gemm(lds, XB, (const bf16_t*)(ws + WS_WKVQ), 2048, 1024, E); }
    SEAM(10);
    if (PH(11)) attn_phase(p, lds, tid, lane, wave);
    SEAM(11);
    if (PH(12)) run_gemm_mix(lds, ws, OB, (const bf16_t*)(ws + WS_WOB), 1024);
    SEAM(12);
    if (PH(13)) thin_phase<false, false>(p, p.in[I_NMIXPOST] + 1024, lane, wave);
    SEAM(13);
    if (PH(14)) { EpiUp E{ws}; run_gemm(lds, XB, (const bf16_t*)(ws + WS_WUP1), 4096, 1024, E); }
    SEAM(14);
    if (PH(15)) run_gemm_mix(lds, ws, HB, (const bf16_t*)(ws + WS_WDN1), 4096);
    SEAM(15);
    if (PH(16)) thin_phase<false, true>(p, p.in[I_NMLPPOST] + 1024, lane, wave);
#undef PH
#undef SEAM
}
}

extern "C" void kernel_launch(void* const* d_in, const int* in_sizes, int n_in, void* d_out, int out_size, void* d_ws, size_t ws_size, hipStream_t stream) {
    static int grid = 0;
    if (grid == 0) {
        if (n_in != 24 || ws_size < mk::WS_END) { fprintf(stderr, "kernel_launch: need 24 inputs and >= %zu bytes of workspace; got %d, %zu\n", (size_t)mk::WS_END, n_in, ws_size); grid = -1; return; }
        int dev = 0, cus = 0, per_cu = 0;
        if (hipGetDevice(&dev) != hipSuccess || hipDeviceGetAttribute(&cus, hipDeviceAttributeMultiprocessorCount, dev) != hipSuccess) { grid = -1; return; }
        if (hipFuncSetAttribute((const void*)mk::yoco_fwd, hipFuncAttributeMaxDynamicSharedMemorySize, mk::LDS_BYTES) != hipSuccess) { fprintf(stderr, "kernel_launch: hipFuncSetAttribute failed\n"); grid = -1; return; }
        if (hipOccupancyMaxActiveBlocksPerMultiprocessor(&per_cu, (const void*)mk::yoco_fwd, 512, mk::LDS_BYTES) != hipSuccess || per_cu < 1) { fprintf(stderr, "kernel_launch: occupancy query says %d\n", per_cu); per_cu = 1; }
        (void)hipGetLastError();
        grid = cus;
    }
    if (grid < 0) return;
    mk::Params prm{};
    for (int i = 0; i < 24; ++i) prm.in[i] = (const float*)d_in[i];
    prm.out = (float*)d_out; prm.ws = (unsigned char*)d_ws;
#if defined(MK_PROBE_MASK)
    { prm.mask = MK_PROBE_MASK; void* pa[] = {&prm}; (void)hipLaunchCooperativeKernel((const void*)mk::yoco_fwd, dim3(grid), dim3(512), pa, mk::LDS_BYTES, stream); }
#endif
    prm.mask = 0x1ffffu;
    void* args[] = {&prm};
    hipError_t e = hipLaunchCooperativeKernel((const void*)mk::yoco_fwd, dim3(grid), dim3(512), args, mk::LDS_BYTES, stream);
    if (e != hipSuccess) fprintf(stderr, "kernel_launch: cooperative launch failed: %s (grid %d)\n", hipGetErrorString(e), grid);
}
```

```cpp
#include <hip/hip_runtime.h>
#include <hip/hip_cooperative_groups.h>
#include <cstdio>
#include <cstdint>
namespace cg = cooperative_groups;

namespace pg8 {
#define PG8_LAS __attribute__((address_space(3)))
typedef unsigned short bf16_t;
typedef short bf16x8 __attribute__((ext_vector_type(8)));
typedef float f32x4 __attribute__((ext_vector_type(4)));
typedef unsigned u32x4 __attribute__((ext_vector_type(4)));
constexpr int BM = 256, BK = 64, HALF = 128, HTB = HALF * BK * 2  , STAGE_BYTES = 8 * HTB, NXCD = 8, WGM = 8;

__host__ __device__ __forceinline__ int lds_byte(int r, int c) { const int st = (r >> 4) * 2 + (c >> 5), rr = r & 15, cc = c & 31, ob = rr * 64 + cc * 2; return st * 1024 + (ob ^ (((ob >> 9) & 1) << 5)); }
__host__ __device__ __forceinline__ void stage_rc(int b, int& R, int& C) { const int st = b / 1024, sb = b % 1024, swz = sb ^ (((sb >> 9) & 1) << 5); R = (st >> 1) * 16 + swz / 64; C = (st & 1) * 32 + (swz % 64) / 2; }
__host__ __device__ __forceinline__ int perm32(int rho) { const int n = rho >> 4, i = rho & 15; return 8 * (i >> 2) + 4 * n + (i & 3); }

struct Unit { int pm, pn, ko; };
struct Gemm { const bf16_t* A; const bf16_t* Bt; int M, N, K, ld; };

struct StaticOrder {
    int nM, nN, nwg, G, c;
    __host__ __device__ void init(int M, int N, int G_, int c_) { nM = M / BM; nN = N / BM; nwg = nM * nN; G = G_; c = c_; }
    __host__ __device__ bool next(int i, Unit& u) const {
        const long L = (long)i * G + c; if (L >= nwg) return false;
        int wgid = (int)L; { const int q = nwg / NXCD, r = nwg % NXCD, xcd = wgid % NXCD, off = wgid / NXCD; wgid = (xcd < r ? xcd * (q + 1) : r * (q + 1) + (xcd - r) * q) + off; }
        const int nig = WGM * nN, gid = wgid / nig, fm = gid * WGM, gsz = (nM - fm) < WGM ? (nM - fm) : WGM;
        u.pm = fm + ((wgid % nig) % gsz); u.pn = (wgid % nig) / gsz; u.ko = 0; return true;
    }
    __device__ __forceinline__ void a_ready(const Unit&) const {}
    __device__ __forceinline__ void done(const Unit&) const {}
};

__device__ __forceinline__ unsigned cvt_pk_bf16(float lo, float hi) { unsigned r; asm volatile("v_cvt_pk_bf16_f32 %0, %1, %2" : "=v"(r) : "v"(lo), "v"(hi)); return r; }
template <class Epi, class Sched, bool ALIGN_EPI = false, bool SP2 = false>
__device__ __forceinline__ void gemm_phase(PG8_LAS unsigned char* lds, const Gemm g, const Sched& S, const Epi& E) {
    int tid = threadIdx.x; asm volatile("" : "+v"(tid));
    const int wid = __builtin_amdgcn_readfirstlane(tid >> 6), lane = tid & 63, wr = wid >> 2, wc = wid & 3, fr = lane & 15, fq = lane >> 4;
    const int K = g.K, nt = K / BK;
    unsigned voffA[2], voffB[2];
#pragma unroll
    for (int i = 0; i < 2; ++i) { int R, C; stage_rc(tid * 16 + i * 8192, R, C); const int Rb = Epi::PERM ? ((R & ~31) + perm32(R & 31)) : R;
        voffA[i] = (unsigned)(R * g.ld + C) * 2u; voffB[i] = (unsigned)(Rb * g.ld + C) * 2u; }
    const size_t kstep = (size_t)(BK * 2);
    const size_t hstep = (size_t)HALF * g.ld * 2;
    const size_t tstep = 2 * hstep;
    const unsigned ldsw = (unsigned)wid * 1024u;
    const int aoff = lds_byte(wr * 64 + fr, fq * 8), boff = lds_byte(wc * 32 + fr, fq * 8);
#define PG8_SA(b, h) (((b) * 2 + (h)) * HTB)
#define PG8_SB(b, h) ((4 + (b) * 2 + (h)) * HTB)
#define PG8_STAGE(bufoff, gbase, voff) do { _Pragma("unroll") for (int _i = 0; _i < 2; ++_i) \
        __builtin_amdgcn_global_load_lds((const unsigned*)((const char*)(gbase) + (voff)[_i]), (PG8_LAS unsigned*)(lds + (bufoff) + ldsw + _i * 8192), 16, 0, 0); } while (0)
#define PG8_LDA(dst, b, h) do { _Pragma("unroll") for (int m = 0; m < 4; ++m) _Pragma("unroll") for (int k = 0; k < 2; ++k) dst[m][k] = *(const PG8_LAS bf16x8*)(lds + PG8_SA(b, h) + aoff + m * 2048 + k * 1024); } while (0)
#define PG8_LDB(dst, b, h) do { _Pragma("unroll") for (int n = 0; n < 2; ++n) _Pragma("unroll") for (int k = 0; k < 2; ++k) dst[n][k] = *(const PG8_LAS bf16x8*)(lds + PG8_SB(b, h) + boff + n * 2048 + k * 1024); } while (0)
#define PG8_MMA(ai, bj, At, Bt) do { __builtin_amdgcn_s_setprio(1); _Pragma("unroll") for (int m = 0; m < 4; ++m) _Pragma("unroll") for (int n = 0; n < 2; ++n) _Pragma("unroll") for (int k = 0; k < 2; ++k) \
        acc[ai][bj][m][n] = __builtin_amdgcn_mfma_f32_16x16x32_bf16(Bt[n][k], At[m][k], acc[ai][bj][m][n], 0, 0, 0); __builtin_amdgcn_s_setprio(0); } while (0)
#define PG8_WAIT_V(n) asm volatile("s_waitcnt vmcnt(" #n ")" ::: "memory")
#define PG8_WAIT_L(n) asm volatile("s_waitcnt lgkmcnt(" #n ")" ::: "memory")
#define PG8_BAR __builtin_amdgcn_s_barrier()
#define PG8_SCHED __builtin_amdgcn_sched_barrier(0)
    Unit cur, nxt; int ui = 0;
    if (!S.next(0, cur)) return;
    f32x4 acc[2][2][4][2];
#pragma unroll
    for (int a = 0; a < 2; ++a)
#pragma unroll
        for (int b = 0; b < 2; ++b)
#pragma unroll
            for (int m = 0; m < 4; ++m)
#pragma unroll
                for (int n = 0; n < 2; ++n) acc[a][b][m][n] = (f32x4){0.f, 0.f, 0.f, 0.f};
    bf16x8 At[4][2], B0[2][2], B1[2][2];
    const char* cA = (const char*)g.A + (size_t)cur.pm * tstep + (size_t)cur.ko * 2; const char* cB = (const char*)g.Bt + (size_t)cur.pn * tstep + (size_t)cur.ko * 2;
    S.a_ready(cur);
    if constexpr (SP2) {
        PG8_STAGE(PG8_SB(0, 0), cB, voffB); PG8_STAGE(PG8_SB(0, 1), cB + hstep, voffB); PG8_STAGE(PG8_SA(0, 0), cA, voffA); PG8_STAGE(PG8_SA(0, 1), cA + hstep, voffA);
        if (wr == 1) PG8_BAR;
        PG8_WAIT_V(2); PG8_BAR;
        PG8_STAGE(PG8_SB(1, 0), cB + kstep, voffB); PG8_STAGE(PG8_SA(1, 0), cA + kstep, voffA); PG8_STAGE(PG8_SB(1, 1), cB + hstep + kstep, voffB);
        PG8_WAIT_V(6); PG8_BAR;
    } else {
        PG8_STAGE(PG8_SB(0, 0), cB, voffB); PG8_STAGE(PG8_SA(0, 0), cA, voffA); PG8_STAGE(PG8_SB(0, 1), cB + hstep, voffB); PG8_STAGE(PG8_SA(0, 1), cA + hstep, voffA);
        if (wr == 1) PG8_BAR;
        PG8_WAIT_V(4); PG8_BAR;
        PG8_STAGE(PG8_SB(1, 0), cB + kstep, voffB); PG8_STAGE(PG8_SA(1, 0), cA + kstep, voffA); PG8_STAGE(PG8_SB(1, 1), cB + hstep + kstep, voffB);
        PG8_WAIT_V(6); PG8_BAR;
    }
    for (;;) {
        const bool has_next = S.next(ui + 1, nxt);
        const char* nA = has_next ? (const char*)g.A + (size_t)nxt.pm * tstep + (size_t)nxt.ko * 2 : cA; const char* nB = has_next ? (const char*)g.Bt + (size_t)nxt.pn * tstep + (size_t)nxt.ko * 2 : cB;
        for (int t = 0; t < nt; t += 2) {
            const bool last = (t == nt - 2);
            const char* a1 = cA + (size_t)(t + 1) * kstep;
            const char* a2 = last ? nA : cA + (size_t)(t + 2) * kstep; const char* b2 = last ? nB : cB + (size_t)(t + 2) * kstep;
            const char* a3 = a2 + kstep; const char* b3 = b2 + kstep;
            if (last && has_next) S.a_ready(nxt);
            if constexpr (SP2) {
            PG8_LDB(B0, 0, 0); PG8_LDB(B1, 0, 1); PG8_SCHED; PG8_LDA(At, 0, 0); PG8_STAGE(PG8_SA(1, 1), a1 + hstep, voffA);
            PG8_WAIT_V(8); PG8_WAIT_L(0); PG8_BAR; PG8_MMA(0, 0, At, B0); PG8_MMA(0, 1, At, B1); PG8_BAR; PG8_SCHED;
            PG8_LDA(At, 0, 1); PG8_STAGE(PG8_SB(0, 0), b2, voffB); PG8_STAGE(PG8_SB(0, 1), b2 + hstep, voffB); PG8_STAGE(PG8_SA(0, 0), a2, voffA);
            PG8_WAIT_V(8); PG8_WAIT_L(0); PG8_BAR; PG8_MMA(1, 0, At, B0); PG8_MMA(1, 1, At, B1); PG8_BAR; PG8_SCHED;
            PG8_LDB(B0, 1, 0); PG8_LDB(B1, 1, 1); PG8_SCHED; PG8_LDA(At, 1, 0); PG8_STAGE(PG8_SA(0, 1), a2 + hstep, voffA);
            PG8_WAIT_V(8); PG8_WAIT_L(0); PG8_BAR; PG8_MMA(0, 0, At, B0); PG8_MMA(0, 1, At, B1); PG8_BAR; PG8_SCHED;
            PG8_LDA(At, 1, 1); PG8_STAGE(PG8_SB(1, 0), b3, voffB); PG8_STAGE(PG8_SB(1, 1), b3 + hstep, voffB); PG8_STAGE(PG8_SA(1, 0), a3, voffA);
            PG8_WAIT_V(8); PG8_WAIT_L(0); PG8_BAR; PG8_MMA(1, 0, At, B0); PG8_MMA(1, 1, At, B1); PG8_BAR; PG8_SCHED;
            } else {
            PG8_LDB(B0, 0, 0); PG8_SCHED; PG8_LDA(At, 0, 0); PG8_STAGE(PG8_SA(1, 1), a1 + hstep, voffA);
            PG8_WAIT_L(8); PG8_BAR; PG8_WAIT_L(0); PG8_MMA(0, 0, At, B0); PG8_BAR; PG8_SCHED;
            PG8_LDB(B1, 0, 1); PG8_STAGE(PG8_SB(0, 0), b2, voffB);
            PG8_BAR; PG8_WAIT_L(0); PG8_MMA(0, 1, At, B1); PG8_BAR;
            PG8_LDA(At, 0, 1); PG8_STAGE(PG8_SA(0, 0), a2, voffA);
            PG8_BAR; PG8_WAIT_L(0); PG8_MMA(1, 0, At, B0); PG8_BAR; PG8_SCHED;
            PG8_STAGE(PG8_SB(0, 1), b2 + hstep, voffB);
            PG8_WAIT_V(6); PG8_BAR; PG8_MMA(1, 1, At, B1); PG8_BAR;
            PG8_LDB(B0, 1, 0); PG8_SCHED; PG8_LDA(At, 1, 0); PG8_STAGE(PG8_SA(0, 1), a2 + hstep, voffA);
            PG8_WAIT_L(8); PG8_BAR; PG8_WAIT_L(0); PG8_MMA(0, 0, At, B0); PG8_BAR; PG8_SCHED;
            PG8_LDB(B1, 1, 1); PG8_STAGE(PG8_SB(1, 0), b3, voffB);
            PG8_BAR; PG8_WAIT_L(0); PG8_MMA(0, 1, At, B1); PG8_BAR;
            PG8_LDA(At, 1, 1); PG8_STAGE(PG8_SA(1, 0), a3, voffA);
            PG8_BAR; PG8_WAIT_L(0); PG8_MMA(1, 0, At, B0); PG8_BAR; PG8_SCHED;
            PG8_STAGE(PG8_SB(1, 1), b3 + hstep, voffB);
            PG8_WAIT_V(6); PG8_BAR; PG8_MMA(1, 1, At, B1); PG8_BAR;
            }
        }
        if constexpr (ALIGN_EPI) { if (wr == 0) PG8_BAR; }
        if constexpr (!Epi::AFTER_DRAIN) { E(acc, cur, wr, wc, fr, fq); S.done(cur); }
        if (!has_next) break;
#pragma unroll
        for (int a = 0; a < 2; ++a)
#pragma unroll
            for (int b = 0; b < 2; ++b)
#pragma unroll
                for (int m = 0; m < 4; ++m)
#pragma unroll
                    for (int n = 0; n < 2; ++n) acc[a][b][m][n] = (f32x4){0.f, 0.f, 0.f, 0.f};
        cur = nxt; cA = nA; cB = nB; ++ui;
        if constexpr (ALIGN_EPI) { if (wr == 1) PG8_BAR; }
    }
    PG8_WAIT_V(0);
    if constexpr (!ALIGN_EPI) { if (wr == 0) PG8_BAR; }
    PG8_BAR;
    if constexpr (Epi::AFTER_DRAIN) { E.fused(acc, cur, wr, wc, fr, fq, lds, wid, lane); S.done(cur); }
#undef PG8_SA
#undef PG8_SB
#undef PG8_STAGE
#undef PG8_LDA
#undef PG8_LDB
#undef PG8_MMA
#undef PG8_WAIT_V
#undef PG8_WAIT_L
#undef PG8_BAR
#undef PG8_SCHED
}
}

namespace mk {
using pg8::bf16_t; using pg8::f32x4; using pg8::u32x4; using pg8::bf16x8; using pg8::Unit;
typedef float f32x16 __attribute__((ext_vector_type(16)));
typedef float f32x2 __attribute__((ext_vector_type(2)));
typedef unsigned u32x2 __attribute__((ext_vector_type(2)));
typedef short s16x4 __attribute__((ext_vector_type(4)));
#define DI __device__ __forceinline__
#define LAS __attribute__((address_space(3)))
typedef LAS unsigned char* ldsp;

constexpr int M = 34816, MP = 32768, D = 1024, FF = 4096, NCHUNK = 544, NCHP = 512;
constexpr float EPS = 1e-6f;
constexpr float LAM_INIT = 0.35550906759096934f;
constexpr float QSCALE = 0.18033688011112042f;
constexpr float QA_SCALE = 0.08838834764831845f;
constexpr size_t O_Y = 0, O_SP = 35651584, O_KP = 35913728, O_VP = 52690944, O_SS = 69468160, O_KS = 73662464, O_VS = 74711040;
constexpr size_t MiB = 1u << 20;
constexpr size_t WS_CTL = 0, WS_WIN = 2 * MiB, WS_WOA = 10 * MiB, WS_WUP0 = 12 * MiB, WS_WDN0 = 20 * MiB, WS_WKVQ = 28 * MiB, WS_WOB = 32 * MiB, WS_WUP1 = 34 * MiB, WS_WDN1 = 42 * MiB;
constexpr size_t WS_COS = 50 * MiB, WS_SIN = 50 * MiB + 512 * 1024, WS_RINV = 51 * MiB, WS_DEC = 52 * MiB;
constexpr size_t WS_XB = 56 * MiB, WS_QB = 124 * MiB, WS_VB = 192 * MiB, WS_KB = 192 * MiB, WS_VB2 = 226 * MiB, WS_GATE = 260 * MiB, WS_MIXB = 260 * MiB;
constexpr size_t WS_G = 328 * MiB, WS_UT = 464 * MiB, WS_HB = 328 * MiB, WS_OB = 600 * MiB, WS_END = 720 * MiB;
constexpr int LDS_BYTES = 147456;

struct Params { const float* in[24]; float* out; unsigned char* ws; unsigned mask; unsigned pad; };
enum { I_XP = 0, I_XS, I_STATE, I_CK, I_CV, I_NMIXPRE, I_NMIXPOST, I_NMLPPRE, I_NMLPPOST, I_WUP, I_WDOWN, I_WIN, I_LB, I_GNORM, I_WOA, I_NKV, I_WKV, I_WQ, I_LQ1, I_LK1, I_LQ2, I_LK2, I_SUBLN, I_WOB };

DI unsigned pk2(float lo, float hi) { typedef __bf16 bf2 __attribute__((ext_vector_type(2))); f32x2 v = {lo, hi}; bf2 b = __builtin_convertvector(v, bf2); return __builtin_bit_cast(unsigned, b); }
DI float bflo(unsigned w) { return __uint_as_float(w << 16); }
DI float bfhi(unsigned w) { return __uint_as_float(w & 0xffff0000u); }
DI float bf2f(unsigned short u) { return __uint_as_float((unsigned)u << 16); }
DI unsigned short f2bf(float f) { return (unsigned short)(pk2(f, 0.f) & 0xffffu); }
DI float wave_sum(float v) {
#pragma unroll
    for (int o = 1; o < 64; o <<= 1) v += __shfl_xor(v, o);
    return v;
}
DI float fsigmoid(float x) { return __builtin_amdgcn_rcpf(1.f + __expf(-x)); }
DI float fsilu(float x) { return x * fsigmoid(x); }
DI int crow(int r, int hi) { return (r & 3) + 8 * (r >> 2) + 4 * hi; }
#define LDS_WAIT() asm volatile("s_waitcnt lgkmcnt(0)" ::: "memory")
DI f32x16 mfma32(bf16x8 a, bf16x8 b, f32x16 c) { return __builtin_amdgcn_mfma_f32_32x32x16_bf16(a, b, c, 0, 0, 0); }
DI f32x16 zero16() { f32x16 z;
#pragma unroll
    for (int i = 0; i < 16; ++i) z[i] = 0.f; return z; }
DI bf16x8 pack8(const f32x16& x, int s) {
    u32x4 p; p.x = pk2(x[8 * s + 0], x[8 * s + 1]); p.y = pk2(x[8 * s + 2], x[8 * s + 3]); p.z = pk2(x[8 * s + 4], x[8 * s + 5]); p.w = pk2(x[8 * s + 6], x[8 * s + 7]);
    return __builtin_bit_cast(bf16x8, p);
}
typedef short v4i16_t __attribute__((ext_vector_type(4)));
DI s16x4 vtr(LAS const unsigned char* p) { return __builtin_bit_cast(s16x4, __builtin_amdgcn_ds_read_tr16_b64_v4i16((LAS v4i16_t*)p)); }

struct EpiIn {
    static constexpr bool PERM = true, AFTER_DRAIN = false;
    unsigned char* ws; const float* lbl;
    DI void operator()(const f32x4 (&acc)[2][2][4][2], const Unit& u, int wr, int wc, int fr, int fq) const {
        const float* rinv = (const float*)(ws + WS_RINV); bf16_t* QB = (bf16_t*)(ws + WS_QB); bf16_t* G = (bf16_t*)(ws + WS_G); bf16_t* VB = (bf16_t*)(ws + WS_VB); bf16_t* GATE = (bf16_t*)(ws + WS_GATE);
        const int part = u.pn >> 2; const int cbase = (u.pn & 3) * 256 + wc * 32 + 8 * fq;
        float lb[2][8];
        if (part == 1) {
#pragma unroll
            for (int bj = 0; bj < 2; ++bj)
#pragma unroll
                for (int i = 0; i < 8; ++i) { const int c = cbase + bj * 128 + i; lb[bj][i] = fsigmoid(lbl[c] - lbl[1024 + c]); }
        }
#pragma unroll
        for (int ai = 0; ai < 2; ++ai)
#pragma unroll
            for (int m = 0; m < 4; ++m) {
                const int row = u.pm * 256 + ai * 128 + wr * 64 + m * 16 + fr; const float rs = rinv[row];
#pragma unroll
                for (int bj = 0; bj < 2; ++bj) {
                    const int c = cbase + bj * 128; float v[8];
#pragma unroll
                    for (int i = 0; i < 4; ++i) { v[i] = acc[ai][bj][m][0][i] * rs; v[4 + i] = acc[ai][bj][m][1][i] * rs; }
                    if (part == 1) {
                        f32x4 g0, g1;
#pragma unroll
                        for (int i = 0; i < 8; ++i) { const float f = lb[bj][i] + (1.f - lb[bj][i]) * fsigmoid(v[i]); const float g = __logf(f); if (i < 4) g0[i] = g; else g1[i - 4] = g; }
                        u32x4 w; w.x = pk2(g0[0], g0[1]); w.y = pk2(g0[2], g0[3]); w.z = pk2(g1[0], g1[1]); w.w = pk2(g1[2], g1[3]); *(u32x4*)(G + (size_t)row * 1024 + c) = w;
                    } else {
                        bf16_t* o = (part == 0 ? QB : (part == 2 ? VB : GATE)) + (size_t)row * 1024 + c;
                        if (part == 0) {
#pragma unroll
                            for (int i = 0; i < 8; ++i) v[i] = fsilu(v[i]) * QA_SCALE;
                        } else if (part == 3) {
#pragma unroll
                            for (int i = 0; i < 8; ++i) v[i] = fsilu(v[i]);
                        }
                        u32x4 w; w.x = pk2(v[0], v[1]); w.y = pk2(v[2], v[3]); w.z = pk2(v[4], v[5]); w.w = pk2(v[6], v[7]); *(u32x4*)o = w;
                    }
                }
            }
    }
};
struct EpiUp {
    static constexpr bool PERM = true, AFTER_DRAIN = false;
    unsigned char* ws;
    DI void operator()(const f32x4 (&acc)[2][2][4][2], const Unit& u, int wr, int wc, int fr, int fq) const {
        const float* rinv = (const float*)(ws + WS_RINV); bf16_t* HB = (bf16_t*)(ws + WS_HB);
        const int cbase = u.pn * 256 + wc * 32 + 8 * fq;
#pragma unroll
        for (int ai = 0; ai < 2; ++ai)
#pragma unroll
            for (int m = 0; m < 4; ++m) {
                const int row = u.pm * 256 + ai * 128 + wr * 64 + m * 16 + fr; const float rs = rinv[row];
#pragma unroll
                for (int bj = 0; bj < 2; ++bj) {
                    float v[8];
#pragma unroll
                    for (int i = 0; i < 4; ++i) { v[i] = acc[ai][bj][m][0][i] * rs; v[4 + i] = acc[ai][bj][m][1][i] * rs; }
#pragma unroll
                    for (int i = 0; i < 8; ++i) { const float t = fmaxf(v[i], 0.f); v[i] = t * t; }
                    u32x4 w; w.x = pk2(v[0], v[1]); w.y = pk2(v[2], v[3]); w.z = pk2(v[4], v[5]); w.w = pk2(v[6], v[7]);
                    *(u32x4*)(HB + (size_t)row * FF + cbase + bj * 128) = w;
                }
            }
    }
};
struct EpiMix {
    static constexpr bool PERM = true, AFTER_DRAIN = false;
    unsigned char* ws;
    DI void operator()(const f32x4 (&acc)[2][2][4][2], const Unit& u, int wr, int wc, int fr, int fq) const {
        bf16_t* MIXB = (bf16_t*)(ws + WS_MIXB);
        const int cbase = u.pn * 256 + wc * 32 + 8 * fq;
#pragma unroll
        for (int ai = 0; ai < 2; ++ai)
#pragma unroll
            for (int m = 0; m < 4; ++m) {
                const int row = u.pm * 256 + ai * 128 + wr * 64 + m * 16 + fr;
#pragma unroll
                for (int bj = 0; bj < 2; ++bj) {
                    const f32x4 a = acc[ai][bj][m][0], b = acc[ai][bj][m][1];
                    u32x4 w; w.x = pk2(a[0], a[1]); w.y = pk2(a[2], a[3]); w.z = pk2(b[0], b[1]); w.w = pk2(b[2], b[3]);
                    *(u32x4*)(MIXB + (size_t)row * 1024 + cbase + bj * 128) = w;
                }
            }
    }
};
struct EpiKvq {
    static constexpr bool PERM = true, AFTER_DRAIN = false;
    unsigned char* ws; float* out;
    DI void operator()(const f32x4 (&acc)[2][2][4][2], const Unit& u, int wr, int wc, int fr, int fq) const {
        const float* rinv = (const float*)(ws + WS_RINV); bf16_t* KB = (bf16_t*)(ws + WS_KB); bf16_t* VB2 = (bf16_t*)(ws + WS_VB2); bf16_t* QB2 = (bf16_t*)(ws + WS_QB); const float* COS = (const float*)(ws + WS_COS); const float* SIN = (const float*)(ws + WS_SIN);
        const int sec = u.pn < 2 ? 0 : (u.pn < 4 ? 1 : 2);
        const int cbase = u.pn * 256 + wc * 32 + 8 * fq;
        const bool rot = (sec != 1) && ((wc & 1) == 0);
#pragma unroll
        for (int ai = 0; ai < 2; ++ai)
#pragma unroll
            for (int m = 0; m < 4; ++m) {
                const int row = u.pm * 256 + ai * 128 + wr * 64 + m * 16 + fr; const float rs = rinv[row];
                const int pos = row < MP ? (row & 16383) : 4096 + ((row - MP) & 63);
                f32x4 c0, c1, s0, s1;
                if (rot) { c0 = *(const f32x4*)(COS + pos * 8); c1 = *(const f32x4*)(COS + pos * 8 + 4); s0 = *(const f32x4*)(SIN + pos * 8); s1 = *(const f32x4*)(SIN + pos * 8 + 4); }
#pragma unroll
                for (int bj = 0; bj < 2; ++bj) {
                    const int c = cbase + bj * 128; float v[8];
#pragma unroll
                    for (int i = 0; i < 4; ++i) { v[i] = acc[ai][bj][m][0][i] * rs; v[4 + i] = acc[ai][bj][m][1][i] * rs; }
                    if (rot) {
#pragma unroll
                        for (int i = 0; i < 8; ++i) {
                            const float pv = __shfl_xor(v[i], 16);
                            const float cs = i < 4 ? c0[i & 3] : c1[i & 3], sn = i < 4 ? s0[i & 3] : s1[i & 3];
                            const float r0 = v[i] * cs - pv * sn, r1 = v[i] * cs + pv * sn;
                            v[i] = fq == 0 ? r0 : (fq == 1 ? r1 : v[i]);
                        }
                    }
                    if (sec == 2) {
#pragma unroll
                        for (int i = 0; i < 8; ++i) v[i] *= QSCALE;
                        u32x4 w; w.x = pk2(v[0], v[1]); w.y = pk2(v[2], v[3]); w.z = pk2(v[4], v[5]); w.w = pk2(v[6], v[7]);
                        *(u32x4*)(QB2 + (size_t)row * 1024 + (c - 1024)) = w;
                    } else {
                        const int cc = sec == 0 ? c : c - 512;
                        float* o = out + (row < MP ? (sec == 0 ? O_KP : O_VP) + (size_t)row * 512 : (sec == 0 ? O_KS : O_VS) + (size_t)(row - MP) * 512) + cc;
                        *(f32x4*)o = (f32x4){v[0], v[1], v[2], v[3]}; *(f32x4*)(o + 4) = (f32x4){v[4], v[5], v[6], v[7]};
                        u32x4 w; w.x = pk2(v[0], v[1]); w.y = pk2(v[2], v[3]); w.z = pk2(v[4], v[5]); w.w = pk2(v[6], v[7]);
                        *(u32x4*)((sec == 0 ? KB : VB2) + (size_t)row * 512 + cc) = w;
                    }
                }
            }
    }
};

DI void transpose_item(const float* W, int K, int N, bf16_t* WT, int row_off, const float* gain, LAS float* scr, int item, int lane) {
    const int nblk = N / 32, kb = item / nblk, nb = item % nblk, k0 = 64 * kb, n0 = 32 * nb;
#pragma unroll 8
    for (int i = 0; i < 32; ++i) { const int kk = 2 * i + (lane >> 5); float w = W[(size_t)(k0 + kk) * N + n0 + (lane & 31)]; if (gain) w *= gain[k0 + kk]; scr[kk * 33 + (lane & 31)] = w; }
    LDS_WAIT(); asm volatile("" ::: "memory");
    const int c = lane & 7;
#pragma unroll
    for (int j = 0; j < 4; ++j) { const int n = (lane >> 3) + 8 * j; const LAS float* s = scr + (8 * c) * 33 + n;
        u32x4 o; o.x = pk2(s[0 * 33], s[1 * 33]); o.y = pk2(s[2 * 33], s[3 * 33]); o.z = pk2(s[4 * 33], s[5 * 33]); o.w = pk2(s[6 * 33], s[7 * 33]);
        *(u32x4*)(WT + (size_t)(row_off + n0 + n) * K + k0 + 8 * c) = o; }
    LDS_WAIT(); asm volatile("" ::: "memory");
}
DI void phase0(const Params& p, ldsp lds, int tid, int lane, int wave, unsigned full) {
    unsigned char* ws = p.ws;
    if (blockIdx.x == 0) { unsigned* ctl = (unsigned*)(ws + WS_CTL); for (int i = tid; i < 8192; i += 512) ctl[i] = 0u; }
    if (!full) return;
    const int gw = blockIdx.x * 8 + wave, NGW = gridDim.x * 8;
    LAS float* scr = (LAS float*)(lds + wave * 16384);
    constexpr int I_A = 16 * 128, I_B = 16 * 32, I_C = 64 * 32;
    constexpr int NITEMS = 4 * I_A + 4 * I_B + 2 * I_C - I_A;
    static_assert(NITEMS == 3 * I_A + 4 * I_B + 2 * I_C, "items");
    for (int it = gw; it < NITEMS; it += NGW) {
        int r = it;
        if (r < I_A) { transpose_item(p.in[I_WIN], 1024, 4096, (bf16_t*)(ws + WS_WIN), 0, p.in[I_NMIXPRE], scr, r, lane); continue; } r -= I_A;
        if (r < I_A) { transpose_item(p.in[I_WUP], 1024, 4096, (bf16_t*)(ws + WS_WUP0), 0, p.in[I_NMLPPRE], scr, r, lane); continue; } r -= I_A;
        if (r < I_A) { transpose_item(p.in[I_WUP] + (size_t)1024 * 4096, 1024, 4096, (bf16_t*)(ws + WS_WUP1), 0, p.in[I_NMLPPRE] + 1024, scr, r, lane); continue; } r -= I_A;
        if (r < I_C) { transpose_item(p.in[I_WDOWN], 4096, 1024, (bf16_t*)(ws + WS_WDN0), 0, nullptr, scr, r, lane); continue; } r -= I_C;
        if (r < I_C) { transpose_item(p.in[I_WDOWN] + (size_t)4096 * 1024, 4096, 1024, (bf16_t*)(ws + WS_WDN1), 0, nullptr, scr, r, lane); continue; } r -= I_C;
        if (r < I_B) { transpose_item(p.in[I_WOA], 1024, 1024, (bf16_t*)(ws + WS_WOA), 0, nullptr, scr, r, lane); continue; } r -= I_B;
        if (r < I_B) { transpose_item(p.in[I_WKV], 1024, 1024, (bf16_t*)(ws + WS_WKVQ), 0, p.in[I_NKV], scr, r, lane); continue; } r -= I_B;
        if (r < I_B) { transpose_item(p.in[I_WQ], 1024, 1024, (bf16_t*)(ws + WS_WKVQ), 1024, p.in[I_NMIXPRE] + 1024, scr, r, lane); continue; } r -= I_B;
        transpose_item(p.in[I_WOB], 1024, 1024, (bf16_t*)(ws + WS_WOB), 0, nullptr, scr, r, lane);
    }
    float* RINV = (float*)(ws + WS_RINV); bf16_t* XB = (bf16_t*)(ws + WS_XB);
    for (int m = gw; m < M; m += NGW) {
        const float* xr = m < MP ? p.in[I_XP] + (size_t)m * 1024 : p.in[I_XS] + (size_t)(m - MP) * 1024;
        f32x4 v[4]; float s = 0.f;
#pragma unroll
        for (int j = 0; j < 4; ++j) { v[j] = ((const f32x4*)xr)[lane + 64 * j]; s += (v[j].x * v[j].x + v[j].y * v[j].y) + (v[j].z * v[j].z + v[j].w * v[j].w); }
        s = wave_sum(s);
        if (lane == 0) RINV[m] = rsqrtf(s * (1.f / 1024.f) + EPS);
        u32x2* o = (u32x2*)(XB + (size_t)m * 1024) + lane;
#pragma unroll
        for (int j = 0; j < 4; ++j) { u32x2 w; w.x = pk2(v[j].x, v[j].y); w.y = pk2(v[j].z, v[j].w); o[64 * j] = w; }
    }
    float* COS = (float*)(ws + WS_COS); float* SIN = (float*)(ws + WS_SIN);
    for (int i = blockIdx.x * 512 + tid; i < 16384 * 8; i += gridDim.x * 512) {
        const int pos = i >> 3, d = i & 7;
        const double f = d == 0 ? 1.0 : d == 1 ? 0.19392274474868576 : d == 2 ? 0.03760603093086393 : d == 3 ? 0.007292664737217109 : d == 4 ? 0.001414213562373095 : d == 5 ? 0.0002742481756762073 : d == 6 ? 5.318295896944988e-05 : 1.031338537721246e-05;
        const float invf = (float)f;
        const float angf = (float)pos * invf;
        const double rev = (double)angf * 0.15915494309189535;
        const float fr = (float)(rev - __builtin_floor(rev));
        COS[i] = __builtin_amdgcn_cosf(fr); SIN[i] = __builtin_amdgcn_sinf(fr);
    }
}

template <bool FIRST, bool LAST> DI void thin_phase(const Params& p, const float* gpost, int lane, int wave) {
    unsigned char* ws = p.ws;
    const int gw = blockIdx.x * 8 + wave, NGW = gridDim.x * 8;
    float* RINV = (float*)(ws + WS_RINV); bf16_t* XB = (bf16_t*)(ws + WS_XB); const bf16_t* MIXB = (const bf16_t*)(ws + WS_MIXB); float* Y = p.out + O_Y;
    f32x4 gp[4];
#pragma unroll
    for (int j = 0; j < 4; ++j) gp[j] = ((const f32x4*)gpost)[lane + 64 * j];
    for (int m = gw; m < M; m += NGW) {
        const u32x2* mx = (const u32x2*)(MIXB + (size_t)m * 1024) + lane;
        f32x4 mv[4], hv[4]; float s = 0.f;
        if (FIRST) {
            const float* hr = m < MP ? p.in[I_XP] + (size_t)m * 1024 : p.in[I_XS] + (size_t)(m - MP) * 1024;
#pragma unroll
            for (int j = 0; j < 4; ++j) hv[j] = ((const f32x4*)hr)[lane + 64 * j];
        } else {
            const u32x2* hx = (const u32x2*)(XB + (size_t)m * 1024) + lane;
#pragma unroll
            for (int j = 0; j < 4; ++j) { const u32x2 w = hx[64 * j]; hv[j] = (f32x4){bflo(w.x), bfhi(w.x), bflo(w.y), bfhi(w.y)}; }
        }
        if (m < MP) {
#pragma unroll
            for (int j = 0; j < 4; ++j) { const u32x2 w = mx[64 * j]; mv[j] = (f32x4){bflo(w.x), bfhi(w.x), bflo(w.y), bfhi(w.y)}; }
        } else {
            const f32x4* pp = (const f32x4*)((const float*)(ws + WS_QB) + (size_t)(m - MP) * 1024) + lane;
#pragma unroll
            for (int j = 0; j < 4; ++j) { f32x4 a = pp[64 * j];
#pragma unroll
                for (int ks = 1; ks < 8; ++ks) a = a + pp[(size_t)ks * 2048 * 256 + 64 * j];
                mv[j] = a; }
        }
#pragma unroll
        for (int j = 0; j < 4; ++j) s += (mv[j].x * mv[j].x + mv[j].y * mv[j].y) + (mv[j].z * mv[j].z + mv[j].w * mv[j].w);
        s = wave_sum(s);
        const float r1 = rsqrtf(s * (1.f / 1024.f) + EPS);
#pragma unroll
        for (int j = 0; j < 4; ++j) hv[j] = hv[j] + mv[j] * r1 * gp[j];
        if (LAST) {
#pragma unroll
            for (int j = 0; j < 4; ++j) ((f32x4*)(Y + (size_t)m * 1024))[lane + 64 * j] = hv[j];
        } else {
            u32x2 w[4]; float s2 = 0.f;
#pragma unroll
            for (int j = 0; j < 4; ++j) { w[j].x = pk2(hv[j].x, hv[j].y); w[j].y = pk2(hv[j].z, hv[j].w);
                const float a = bflo(w[j].x), b = bfhi(w[j].x), c = bflo(w[j].y), d = bfhi(w[j].y); s2 += (a * a + b * b) + (c * c + d * d); }
            s2 = wave_sum(s2);
            if (lane == 0) RINV[m] = rsqrtf(s2 * (1.f / 1024.f) + EPS);
            u32x2* o = (u32x2*)(XB + (size_t)m * 1024) + lane;
#pragma unroll
            for (int j = 0; j < 4; ++j) o[64 * j] = w[j];
        }
    }
}

DI void hgrn_a(const Params& p, ldsp lds, int tid, int lane, int wave) {
    unsigned char* ws = p.ws;
    const bf16_t* G = (const bf16_t*)(ws + WS_G); const bf16_t* VB = (const bf16_t*)(ws + WS_VB); float* RU = (float*)(ws + WS_UT); float* RD = (float*)(ws + WS_DEC);
    LAS float* TOT = (LAS float*)(lds + 36864); LAS float* DECL = (LAS float*)(lds + 38912);
    const int d = tid & 127, tq = tid >> 7, r = lane & 31, h = lane >> 5, bm = wave >> 1;
    u32x4 rg[2], rv[2];
#define HA_LOAD(u_) do { const int cg_ = (u_) >> 3, hh_ = (u_) & 7; \
        _Pragma("unroll") for (int k = 0; k < 2; ++k) { const int idx_ = tid + 512 * k; const size_t o_ = (size_t)(cg_ * 64 + (idx_ >> 4)) * 1024 + hh_ * 128 + (idx_ & 15) * 8; \
            rg[k] = *(const u32x4*)(G + o_); rv[k] = *(const u32x4*)(VB + o_); } } while (0)
    for (int run = blockIdx.x; run < 256; run += gridDim.x) {
        const int bh = run >> 4, rr = run & 15, hh = bh & 7, cg0 = (bh >> 3) * 256 + rr * 16;
        f32x16 S[2]; S[0] = zero16(); S[1] = zero16(); float bsum = 0.f;
        HA_LOAD(cg0 * 8 + hh);
        for (int ci = 0; ci < 16; ++ci) {
            const int cgi = cg0 + ci;
#pragma unroll
            for (int k = 0; k < 2; ++k) { const int idx = tid + 512 * k, off = (idx >> 4) * 272 + (idx & 15) * 16; *(LAS u32x4*)(lds + 40960 + off) = rg[k]; *(LAS u32x4*)(lds + 58368 + off) = rv[k]; }
            __syncthreads();
            float gv[16]; unsigned short vv[16];
#pragma unroll
            for (int i = 0; i < 16; ++i) { const int e = ((16 * tq + i) * 136 + d) * 2; gv[i] = bf2f(*(const LAS unsigned short*)(lds + 40960 + e)); vv[i] = *(const LAS unsigned short*)(lds + 58368 + e); }
            float bl[16], kk[16];
            { float c = 0.f;
#pragma unroll
              for (int i = 0; i < 16; ++i) { kk[i] = 1.f - __expf(gv[i]); c += gv[i]; bl[i] = c; }
              TOT[tq * 128 + d] = c; }
            { u32x4 x0, x1;
              x0.x = vv[0] | ((unsigned)vv[1] << 16); x0.y = vv[2] | ((unsigned)vv[3] << 16); x0.z = vv[4] | ((unsigned)vv[5] << 16); x0.w = vv[6] | ((unsigned)vv[7] << 16);
              x1.x = vv[8] | ((unsigned)vv[9] << 16); x1.y = vv[10] | ((unsigned)vv[11] << 16); x1.z = vv[12] | ((unsigned)vv[13] << 16); x1.w = vv[14] | ((unsigned)vv[15] << 16);
              *(LAS u32x4*)(lds + 18432 + d * 144 + tq * 32) = x0; *(LAS u32x4*)(lds + 18432 + d * 144 + tq * 32 + 16) = x1; }
            if (ci + 1 < 16) HA_LOAD((cgi + 1) * 8 + hh);
            __syncthreads();
            float off = 0.f, blast = 0.f;
#pragma unroll
            for (int j = 0; j < 4; ++j) { const float t = TOT[j * 128 + d]; blast += t; if (j < tq) off += t; }
            { u32x4 w0, w1; float e[16];
#pragma unroll
              for (int i = 0; i < 16; ++i) e[i] = kk[i] * __expf(blast - (bl[i] + off));
              w0.x = pk2(e[0], e[1]); w0.y = pk2(e[2], e[3]); w0.z = pk2(e[4], e[5]); w0.w = pk2(e[6], e[7]); w1.x = pk2(e[8], e[9]); w1.y = pk2(e[10], e[11]); w1.z = pk2(e[12], e[13]); w1.w = pk2(e[14], e[15]);
              *(LAS u32x4*)(lds + d * 144 + tq * 32) = w0; *(LAS u32x4*)(lds + d * 144 + tq * 32 + 16) = w1; }
            if (tq == 0) { DECL[d] = __expf(blast); bsum += blast; }
            __syncthreads();
#pragma unroll
            for (int q = 0; q < 2; ++q) {
                const int bn = 2 * (wave & 1) + q; const float dc = DECL[32 * bn + r];
                f32x16 acc = S[q] * dc;
#pragma unroll
                for (int ks = 0; ks < 4; ++ks) {
                    const bf16x8 a = *(const LAS bf16x8*)(lds + 18432 + (32 * bm + r) * 144 + (16 * ks + 8 * h) * 2);
                    const bf16x8 b = *(const LAS bf16x8*)(lds + (32 * bn + r) * 144 + (16 * ks + 8 * h) * 2);
                    acc = mfma32(a, b, acc);
                }
                S[q] = acc;
            }
            __syncthreads();
        }
#pragma unroll
        for (int q = 0; q < 2; ++q) { const int bn = 2 * (wave & 1) + q; float* up = RU + ((size_t)run * 128) * 128 + 32 * bn + r;
#pragma unroll
            for (int reg = 0; reg < 16; ++reg) up[(size_t)(32 * bm + crow(reg, h)) * 128] = S[q][reg]; }
        if (tq == 0) RD[run * 128 + d] = __expf(bsum);
    }
#undef HA_LOAD
}
DI void hgrn_c(const Params& p, ldsp lds, int tid, int lane, int wave) {
    unsigned char* ws = p.ws;
    const bf16_t* G = (const bf16_t*)(ws + WS_G); const bf16_t* VB = (const bf16_t*)(ws + WS_VB); const bf16_t* QB = (const bf16_t*)(ws + WS_QB); const bf16_t* GATE = (const bf16_t*)(ws + WS_GATE);
    const float* RU = (const float*)(ws + WS_UT); const float* RD = (const float*)(ws + WS_DEC); bf16_t* OB = (bf16_t*)(ws + WS_OB); const float* gn = p.in[I_GNORM];
    LAS float* TOT = (LAS float*)(lds + 105472); LAS float* RED = (LAS float*)(lds + 107520); LAS float* DECL = (LAS float*)(lds + 126976);
    LAS bf16_t* QT = (LAS bf16_t*)(lds); LAS bf16_t* KT = (LAS bf16_t*)(lds + 17408); LAS bf16_t* QH = (LAS bf16_t*)(lds + 34816); LAS bf16_t* STl = (LAS bf16_t*)(lds + 70656);
    const int d = tid & 127, tq = tid >> 7, r = lane & 31, h = lane >> 5;
    const int dvb = wave & 3, tb = wave >> 2, bm = wave >> 1;
    u32x4 rg[2], rv[2], rq[2];
#define HC_LOAD(u_) do { const int cg_ = (u_) >> 3, hh_ = (u_) & 7; \
        _Pragma("unroll") for (int k = 0; k < 2; ++k) { const int idx_ = tid + 512 * k; const size_t o_ = (size_t)(cg_ * 64 + (idx_ >> 4)) * 1024 + hh_ * 128 + (idx_ & 15) * 8; \
            rg[k] = *(const u32x4*)(G + o_); rv[k] = *(const u32x4*)(VB + o_); rq[k] = *(const u32x4*)(QB + o_); } } while (0)
    for (int run = blockIdx.x; run < 512; run += gridDim.x) {
        const bool smp = run >= 256;
        int hh, cg0, nch, sidx, rr = 0;
        if (!smp) { const int bh = run >> 4; rr = run & 15; hh = bh & 7; cg0 = (bh >> 3) * 256 + rr * 16; nch = 16; sidx = bh; }
        else { const int bs = (run - 256) >> 3; hh = run & 7; cg0 = NCHP + bs; nch = 1; sidx = bs * 8 + hh; }
        HC_LOAD(cg0 * 8 + hh);
        f32x16 S[2];
        if (smp) {
#pragma unroll
            for (int q = 0; q < 2; ++q) { const int dk = 32 * (2 * (wave & 1) + q) + r; const float* sp = p.in[I_STATE] + ((size_t)sidx * 128 + dk) * 128;
#pragma unroll
                for (int g4 = 0; g4 < 4; ++g4) { const f32x4 v = *(const f32x4*)(sp + 32 * bm + 8 * g4 + 4 * h); S[q][4 * g4] = v.x; S[q][4 * g4 + 1] = v.y; S[q][4 * g4 + 2] = v.z; S[q][4 * g4 + 3] = v.w; } }
        } else {
            S[0] = zero16(); S[1] = zero16();
            for (int j = 0; j < rr; ++j) { const int rj = (run & ~15) + j;
#pragma unroll
                for (int q = 0; q < 2; ++q) { const int dk = 32 * (2 * (wave & 1) + q) + r; const float dc = RD[rj * 128 + dk]; const float* up = RU + ((size_t)rj * 128) * 128 + dk;
#pragma unroll
                    for (int reg = 0; reg < 16; ++reg) S[q][reg] = dc * S[q][reg] + up[(size_t)(32 * bm + crow(reg, h)) * 128]; } }
        }
        for (int ci = 0; ci < nch; ++ci) {
            const int cgi = cg0 + ci, row0 = cgi * 64;
            const size_t orow = (size_t)(row0 + 32 * tb + r) * 1024 + hh * 128;
            u32x2 gt[4];
#pragma unroll
            for (int g4 = 0; g4 < 4; ++g4) gt[g4] = *(const u32x2*)(GATE + orow + 32 * dvb + 8 * g4 + 4 * h);
#pragma unroll
            for (int k = 0; k < 2; ++k) { const int idx = tid + 512 * k, off = (idx >> 4) * 272 + (idx & 15) * 16; *(LAS u32x4*)(lds + off) = rq[k]; *(LAS u32x4*)(lds + 17408 + off) = rg[k]; *(LAS u32x4*)(lds + 34816 + off) = rv[k]; }
            __syncthreads();
            float gv[16]; unsigned short vv[16], qq[16];
#pragma unroll
            for (int i = 0; i < 16; ++i) { const int e = ((16 * tq + i) * 136 + d) * 2; qq[i] = *(const LAS unsigned short*)(lds + e); gv[i] = bf2f(*(const LAS unsigned short*)(lds + 17408 + e)); vv[i] = *(const LAS unsigned short*)(lds + 34816 + e); }
            float bl[16];
            { float c = 0.f;
#pragma unroll
              for (int i = 0; i < 16; ++i) { c += gv[i]; bl[i] = c; }
              TOT[tq * 128 + d] = c; }
#pragma unroll
            for (int q = 0; q < 2; ++q) { const int dk = 32 * (2 * (wave & 1) + q) + r;
#pragma unroll
                for (int reg = 0; reg < 16; ++reg) STl[(32 * bm + crow(reg, h)) * 136 + dk] = f2bf(S[q][reg]); }
            __syncthreads();
            { float off = 0.f, blast = 0.f;
#pragma unroll
              for (int j = 0; j < 4; ++j) { const float t = TOT[j * 128 + d]; blast += t; if (j < tq) off += t; }
              const float bmid = TOT[d] + TOT[128 + d]; float e[16];
#pragma unroll
              for (int i = 0; i < 16; ++i) { const int t = 16 * tq + i; const float bt = bl[i] + off, kk = 1.f - __expf(gv[i]), qv = bf2f(qq[i]);
                  QT[t * 136 + d] = f2bf(qv * __expf(bt - bmid)); KT[t * 136 + d] = f2bf(kk * __expf(bmid - bt)); QH[t * 136 + d] = f2bf(qv * __expf(bt)); e[i] = kk * __expf(blast - bt); }
              u32x4 w0, w1;
              w0.x = pk2(e[0], e[1]); w0.y = pk2(e[2], e[3]); w0.z = pk2(e[4], e[5]); w0.w = pk2(e[6], e[7]); w1.x = pk2(e[8], e[9]); w1.y = pk2(e[10], e[11]); w1.z = pk2(e[12], e[13]); w1.w = pk2(e[14], e[15]);
              *(LAS u32x4*)(lds + 108544 + d * 144 + tq * 32) = w0; *(LAS u32x4*)(lds + 108544 + d * 144 + tq * 32 + 16) = w1;
              if (tq == 0) DECL[d] = __expf(blast);
              u32x4 x0, x1;
              x0.x = vv[0] | ((unsigned)vv[1] << 16); x0.y = vv[2] | ((unsigned)vv[3] << 16); x0.z = vv[4] | ((unsigned)vv[5] << 16); x0.w = vv[6] | ((unsigned)vv[7] << 16);
              x1.x = vv[8] | ((unsigned)vv[9] << 16); x1.y = vv[10] | ((unsigned)vv[11] << 16); x1.z = vv[12] | ((unsigned)vv[13] << 16); x1.w = vv[14] | ((unsigned)vv[15] << 16);
              *(LAS u32x4*)(lds + 52224 + d * 144 + tq * 32) = x0; *(LAS u32x4*)(lds + 52224 + d * 144 + tq * 32 + 16) = x1; }
            if (ci + 1 < nch) HC_LOAD((cgi + 1) * 8 + hh);
            __syncthreads();
            f32x16 o = zero16();
            for (int sb = 0; sb <= tb; ++sb) {
                f32x16 sc = zero16();
#pragma unroll
                for (int ks = 0; ks < 8; ++ks) {
                    const bf16x8 a = *(const LAS bf16x8*)(lds + 17408 + (32 * sb + r) * 272 + (16 * ks + 8 * h) * 2);
                    const bf16x8 b = *(const LAS bf16x8*)(lds + (32 * tb + r) * 272 + (16 * ks + 8 * h) * 2);
                    sc = mfma32(a, b, sc);
                }
                if (sb == tb) {
#pragma unroll
                    for (int reg = 0; reg < 16; ++reg) if (crow(reg, h) > r) sc[reg] = 0.f;
                }
#pragma unroll
                for (int s2 = 0; s2 < 2; ++s2) {
                    const int kb = 32 * sb + 16 * s2 + 4 * h;
                    const s16x4 lo = *(const LAS s16x4*)(lds + 52224 + (32 * dvb + r) * 144 + kb * 2);
                    const s16x4 hi = *(const LAS s16x4*)(lds + 52224 + (32 * dvb + r) * 144 + (kb + 8) * 2);
                    const bf16x8 a = (bf16x8){lo[0], lo[1], lo[2], lo[3], hi[0], hi[1], hi[2], hi[3]};
                    o = mfma32(a, pack8(sc, s2), o);
                }
            }
#pragma unroll
            for (int ks = 0; ks < 8; ++ks) {
                const bf16x8 a = *(const LAS bf16x8*)(lds + 70656 + (32 * dvb + r) * 272 + (16 * ks + 8 * h) * 2);
                const bf16x8 b = *(const LAS bf16x8*)(lds + 34816 + (32 * tb + r) * 272 + (16 * ks + 8 * h) * 2);
                o = mfma32(a, b, o);
            }
#pragma unroll
            for (int q = 0; q < 2; ++q) {
                const int bn = 2 * (wave & 1) + q; const float dc = DECL[32 * bn + r];
                f32x16 acc = S[q] * dc;
#pragma unroll
                for (int ks = 0; ks < 4; ++ks) {
                    const bf16x8 a = *(const LAS bf16x8*)(lds + 52224 + (32 * bm + r) * 144 + (16 * ks + 8 * h) * 2);
                    const bf16x8 b = *(const LAS bf16x8*)(lds + 108544 + (32 * bn + r) * 144 + (16 * ks + 8 * h) * 2);
                    acc = mfma32(a, b, acc);
                }
                S[q] = acc;
            }
            float ssq = 0.f;
#pragma unroll
            for (int reg = 0; reg < 16; ++reg) ssq += o[reg] * o[reg];
            ssq += __shfl_xor(ssq, 32);
            if (h == 0) RED[(tb * 4 + dvb) * 32 + r] = ssq;
            __syncthreads();
            const float tot = (RED[(tb * 4 + 0) * 32 + r] + RED[(tb * 4 + 1) * 32 + r]) + (RED[(tb * 4 + 2) * 32 + r] + RED[(tb * 4 + 3) * 32 + r]);
            const float rn = rsqrtf(tot * (1.f / 128.f) + EPS);
#pragma unroll
            for (int g4 = 0; g4 < 4; ++g4) { const int dv0 = 32 * dvb + 8 * g4 + 4 * h;
                const f32x4 gg = *(const f32x4*)(gn + dv0);
                u32x2 w; w.x = pk2(o[4 * g4] * rn * gg.x * bflo(gt[g4].x), o[4 * g4 + 1] * rn * gg.y * bfhi(gt[g4].x)); w.y = pk2(o[4 * g4 + 2] * rn * gg.z * bflo(gt[g4].y), o[4 * g4 + 3] * rn * gg.w * bfhi(gt[g4].y));
                *(u32x2*)(OB + orow + dv0) = w; }
            __syncthreads();
        }
        if (smp || rr == 15) {
            float* so = p.out + (smp ? O_SS : O_SP) + (size_t)sidx * 16384;
#pragma unroll
            for (int q = 0; q < 2; ++q) { const int dk = 32 * (2 * (wave & 1) + q) + r;
#pragma unroll
                for (int g4 = 0; g4 < 4; ++g4) *(f32x4*)(so + (size_t)dk * 128 + 32 * bm + 8 * g4 + 4 * h) = (f32x4){S[q][4 * g4], S[q][4 * g4 + 1], S[q][4 * g4 + 2], S[q][4 * g4 + 3]}; }
        }
    }
#undef HC_LOAD
}

constexpr int A_KB0 = 0, A_KBS = 17408, A_VB0 = 34816, A_VBS = 20480, A_ITEM = 76800;
DI void a_ld_bf(u32x4& a, u32x4& b, const bf16_t* T, int rowbase, int kvh, int tid) {
    const int k0 = tid >> 4, c8 = tid & 15;
    a = *(const u32x4*)(T + (size_t)(rowbase + k0) * 512 + kvh * 128 + c8 * 8); b = *(const u32x4*)(T + (size_t)(rowbase + 32 + k0) * 512 + kvh * 128 + c8 * 8);
}
DI void a_st_bf(ldsp buf, int stride, const u32x4& a, const u32x4& b, int tid) {
    const int k0 = tid >> 4, c8 = tid & 15;
    *(LAS u32x4*)(buf + k0 * stride + c8 * 16) = a; *(LAS u32x4*)(buf + (32 + k0) * stride + c8 * 16) = b;
}
DI void a_ld_f32(u32x4 (&st)[4], const float* C, int ctile, int tid) {
    const int k0 = tid >> 5, c4 = tid & 31;
#pragma unroll
    for (int i = 0; i < 4; ++i) st[i] = *(const u32x4*)(C + (size_t)(ctile * 64 + 16 * i + k0) * 512 + c4 * 4);
}
DI void a_st_f32(ldsp buf, int stride, const u32x4 (&st)[4], int tid) {
    const int k0 = tid >> 5, c4 = tid & 31;
#pragma unroll
    for (int i = 0; i < 4; ++i) { u32x2 w; w.x = pk2(__uint_as_float(st[i].x), __uint_as_float(st[i].y)); w.y = pk2(__uint_as_float(st[i].z), __uint_as_float(st[i].w));
        *(LAS u32x2*)(buf + (16 * i + k0) * stride + c4 * 8) = w; }
}
DI void a_qk(f32x16& p0, f32x16& p1, ldsp kb, int koff, const bf16x8 (&qr)[4]) {
    const f32x16 z = zero16();
#pragma unroll
    for (int d0 = 0; d0 < 4; ++d0) {
        const bf16x8 a0 = *(const LAS bf16x8*)(kb + koff + d0 * 32);
        const bf16x8 a1 = *(const LAS bf16x8*)(kb + koff + 32 * 272 + d0 * 32);
        p0 = mfma32(a0, qr[d0], d0 ? p0 : z); p1 = mfma32(a1, qr[d0], d0 ? p1 : z);
    }
}
DI float a_rowmax(const f32x16& p0, const f32x16& p1) {
    float a = fmaxf(fmaxf(p0[0], p0[1]), p1[0]), b = fmaxf(fmaxf(p0[2], p0[3]), p1[1]), c = fmaxf(fmaxf(p0[4], p0[5]), p1[2]), d = fmaxf(fmaxf(p0[6], p0[7]), p1[3]);
    a = fmaxf(fmaxf(a, p0[8]), p1[4]); b = fmaxf(fmaxf(b, p0[9]), p1[5]); c = fmaxf(fmaxf(c, p0[10]), p1[6]); d = fmaxf(fmaxf(d, p0[11]), p1[7]);
    a = fmaxf(fmaxf(a, p0[12]), p1[8]); b = fmaxf(fmaxf(b, p0[13]), p1[9]); c = fmaxf(fmaxf(c, p0[14]), p1[10]); d = fmaxf(fmaxf(d, p0[15]), p1[11]);
    a = fmaxf(fmaxf(a, p1[12]), p1[13]); b = fmaxf(fmaxf(b, p1[14]), p1[15]);
    float m = fmaxf(fmaxf(a, b), fmaxf(c, d));
    return fmaxf(m, __shfl_xor(m, 32));
}
struct AttnCtx { int tid, kvh, kbase, bs, nt; const float* ckp; const float* cvp; const bf16_t* KB; const bf16_t* VB2; int koff, tr_off, h; };
constexpr int F_KB0 = 0, F_KBS = 17408, F_VB0 = 34816, F_VBS = 20480;
DI void a_unit_fp(const Params& p, const AttnCtx& c, ldsp lds, f32x16 (&o)[4], const bf16x8 (&qr)[4], float& mrun, float& lrun, int mm, int lane) {
    const int tid = c.tid, kvh = c.kvh, kbase = c.kbase, bs = c.bs, ncache = 64, nt = 65, r = lane & 31, h = lane >> 5;
    const bf16_t* KB = c.KB; const bf16_t* VB2 = c.VB2;
    const int tr_off = (((lane & 15) >> 2)) * 320 + (16 * ((lane >> 4) & 1) + 4 * (lane & 3)) * 2;
    constexpr int A_KB0 = F_KB0, A_KBS = F_KBS, A_VB0 = F_VB0, A_VBS = F_VBS;
        mrun = -1e30f; lrun = 0.f;
        u32x4 st[8];
        const float* ckp = p.in[I_CK] + ((size_t)bs * 4096 * 4 + kvh) * 128; const float* cvp = p.in[I_CV] + ((size_t)bs * 4096 * 4 + kvh) * 128;
#define A_LOAD(t) do { if ((t) < ncache) { _Pragma("unroll") for (int i_ = 0; i_ < 4; ++i_) { const int key_ = tid >> 3, c4_ = (tid & 7) * 4 + i_; const size_t so_ = (size_t)((t) * 64 + key_) * 512 + c4_ * 4; \
                st[i_] = *(const u32x4*)(ckp + so_); st[4 + i_] = *(const u32x4*)(cvp + so_); } } \
            else { _Pragma("unroll") for (int i_ = 0; i_ < 2; ++i_) { const int key_ = tid >> 3, c8_ = (tid & 7) * 2 + i_; const size_t so_ = (size_t)(kbase + ((t) - ncache) * 64 + key_) * 512 + kvh * 128 + c8_ * 8; \
                st[i_] = *(const u32x4*)(KB + so_); st[2 + i_] = *(const u32x4*)(VB2 + so_); } } } while (0)
#define A_STORE(t) do { const int kb_ = A_KB0 + ((t) & 1) * A_KBS, vb_ = A_VB0 + ((t) & 1) * A_VBS; \
            if ((t) < ncache) { _Pragma("unroll") for (int i_ = 0; i_ < 4; ++i_) { const int key_ = tid >> 3, c4_ = (tid & 7) * 4 + i_; \
                u32x2 a_, b_; a_.x = pk2(__uint_as_float(st[i_].x), __uint_as_float(st[i_].y)); a_.y = pk2(__uint_as_float(st[i_].z), __uint_as_float(st[i_].w)); \
                b_.x = pk2(__uint_as_float(st[4 + i_].x), __uint_as_float(st[4 + i_].y)); b_.y = pk2(__uint_as_float(st[4 + i_].z), __uint_as_float(st[4 + i_].w)); \
                *(LAS u32x2*)(lds + kb_ + key_ * 272 + c4_ * 8) = a_; *(LAS u32x2*)(lds + vb_ + key_ * 320 + c4_ * 8) = b_; } } \
            else { _Pragma("unroll") for (int i_ = 0; i_ < 2; ++i_) { const int key_ = tid >> 3, c8_ = (tid & 7) * 2 + i_; \
                *(LAS u32x4*)(lds + kb_ + key_ * 272 + c8_ * 16) = st[i_]; *(LAS u32x4*)(lds + vb_ + key_ * 320 + c8_ * 16) = st[2 + i_]; } } } while (0)
        A_LOAD(0);
        A_STORE(0);
        __syncthreads();
        for (int t = 0; t < nt; ++t) {
            if (t + 1 < nt) A_LOAD(t + 1);
            const int kb = A_KB0 + (t & 1) * A_KBS, vb = A_VB0 + (t & 1) * A_VBS;
            f32x16 p0 = zero16(), p1 = zero16();
#pragma unroll
            for (int d0 = 0; d0 < 4; ++d0) {
                const bf16x8 a0 = *(const LAS bf16x8*)(lds + kb + r * 272 + (mm * 64 + 16 * d0 + 8 * h) * 2);
                const bf16x8 a1 = *(const LAS bf16x8*)(lds + kb + (32 + r) * 272 + (mm * 64 + 16 * d0 + 8 * h) * 2);
                p0 = mfma32(a0, qr[d0], p0); p1 = mfma32(a1, qr[d0], p1);
            }
            float mx = fmaxf(p0[0], p1[0]);
#pragma unroll
            for (int i = 1; i < 16; ++i) mx = fmaxf(mx, fmaxf(p0[i], p1[i]));
            mx = fmaxf(mx, __shfl_xor(mx, 32));
            if (__any(mx > mrun + 8.f)) {
                const float mn = fmaxf(mrun, mx), al = __builtin_amdgcn_exp2f(mrun - mn);
                lrun *= al; mrun = mn;
#pragma unroll
                for (int i = 0; i < 4; ++i)
#pragma unroll
                    for (int j = 0; j < 16; ++j) o[i][j] *= al;
            }
            float ls = 0.f;
#pragma unroll
            for (int i = 0; i < 16; ++i) { p0[i] = __builtin_amdgcn_exp2f(p0[i] - mrun); p1[i] = __builtin_amdgcn_exp2f(p1[i] - mrun); ls += p0[i] + p1[i]; }
            lrun += ls;
            bf16x8 pk[4]; pk[0] = pack8(p0, 0); pk[1] = pack8(p0, 1); pk[2] = pack8(p1, 0); pk[3] = pack8(p1, 1);
#pragma unroll
            for (int s = 0; s < 4; ++s) {
                const int keyb = 32 * (s >> 1) + 16 * (s & 1) + 4 * h;
#pragma unroll
                for (int db = 0; db < 4; ++db) {
                    const s16x4 lo = vtr(lds + vb + keyb * 320 + db * 64 + tr_off);
                    const s16x4 hi = vtr(lds + vb + (keyb + 8) * 320 + db * 64 + tr_off);
                    const bf16x8 a = (bf16x8){lo[0], lo[1], lo[2], lo[3], hi[0], hi[1], hi[2], hi[3]};
                    o[db] = mfma32(a, pk[s], o[db]);
                }
            }
            if (t + 1 < nt) A_STORE(t + 1);
            __syncthreads();
        }
#undef A_LOAD
#undef A_STORE
}
constexpr int B_K0 = 0, B_V0 = 32768, B_TS = 16384;
DI void a_dma_tile(ldsp dst, const bf16_t* T, int rowbase, int kvh, int wave, int lane, bool isV) {
#pragma unroll
    for (int i = 0; i < 2; ++i) {
        const int j = wave + 8 * i, row = 4 * j + (lane >> 4), pc = lane & 15, cch = isV ? (pc ^ ((row & 3) << 2)) : (pc ^ (row & 15));
        __builtin_amdgcn_global_load_lds((const unsigned*)(T + (size_t)(rowbase + row) * 512 + kvh * 128 + cch * 8), (LAS unsigned*)(dst + j * 1024), 16, 0, 0);
    }
}
DI void b_qk(f32x16& p0, f32x16& p1, ldsp kb, int koff, const bf16x8 (&qr)[4], const f32x16& z) {
#pragma unroll
    for (int d0 = 0; d0 < 4; ++d0) {
        const bf16x8 a0 = *(const LAS bf16x8*)(kb + (koff ^ (d0 * 32)));
        const bf16x8 a1 = *(const LAS bf16x8*)(kb + (koff ^ (d0 * 32)) + 8192);
        p0 = mfma32(a0, qr[d0], d0 ? p0 : z); p1 = mfma32(a1, qr[d0], d0 ? p1 : z);
    }
}
#define SB() __builtin_amdgcn_sched_barrier(0)
DI void b_vfrag(s16x4 (&f)[8], ldsp vb, const int (&trb)[4], int s) {
    const int kimm = (32 * (s >> 1) + 16 * (s & 1)) * 256;
#pragma unroll
    for (int db = 0; db < 4; ++db) { f[2 * db] = vtr(vb + trb[db] + kimm); f[2 * db + 1] = vtr(vb + trb[db] + kimm + 8 * 256); }
}
DI void b_pv(f32x16 (&o)[4], const s16x4 (&f)[8], bf16x8 pk) {
#pragma unroll
    for (int db = 0; db < 4; ++db) { const s16x4 lo = f[2 * db], hi = f[2 * db + 1];
        o[db] = mfma32((bf16x8){lo[0], lo[1], lo[2], lo[3], hi[0], hi[1], hi[2], hi[3]}, pk, o[db]); }
}
DI void b_step(const AttnCtx& c, ldsp lds, int wave, int lane, int t, f32x16& S0, f32x16& S1, f32x16& N0, f32x16& N1, f32x16 (&o)[4], const bf16x8 (&qr)[4], const int (&trb)[4], f32x16& negm, float& lrun) {
    const int tK = min(t + 2, c.nt - 1), tV = min(t + 1, c.nt - 1);
    const bool hasN = t + 1 < c.nt;
    a_dma_tile(lds + B_K0 + (t & 1) * B_TS, c.KB, c.kbase + tK * 64, c.kvh, wave, lane, false);
    a_dma_tile(lds + B_V0 + ((t + 1) & 1) * B_TS, c.VB2, c.kbase + tV * 64, c.kvh, wave, lane, true);
    const ldsp kb = lds + B_K0 + ((t + 1) & 1) * B_TS, vb = lds + B_V0 + (t & 1) * B_TS;
    bf16x8 ka[4], kc[4]; s16x4 f0[8], f1[8]; bf16x8 pk0, pk1, pk2, pk3; float ls = 0.f;
    ka[0] = *(const LAS bf16x8*)(kb + c.koff); ka[1] = *(const LAS bf16x8*)(kb + c.koff + 8192); ka[2] = *(const LAS bf16x8*)(kb + (c.koff ^ 32)); ka[3] = *(const LAS bf16x8*)(kb + (c.koff ^ 32) + 8192);
    SB();
    N0 = mfma32(ka[0], qr[0], negm); N1 = mfma32(ka[1], qr[0], negm); N0 = mfma32(ka[2], qr[1], N0); N1 = mfma32(ka[3], qr[1], N1);
    kc[0] = *(const LAS bf16x8*)(kb + (c.koff ^ 64)); kc[1] = *(const LAS bf16x8*)(kb + (c.koff ^ 64) + 8192); kc[2] = *(const LAS bf16x8*)(kb + (c.koff ^ 96)); kc[3] = *(const LAS bf16x8*)(kb + (c.koff ^ 96) + 8192);
#pragma unroll
    for (int i = 0; i < 16; ++i) { S0[i] = __builtin_amdgcn_exp2f(S0[i]); ls += S0[i]; }
    SB();
    N0 = mfma32(kc[0], qr[2], N0); N1 = mfma32(kc[1], qr[2], N1); N0 = mfma32(kc[2], qr[3], N0); N1 = mfma32(kc[3], qr[3], N1);
    b_vfrag(f0, vb, trb, 0);
    pk0 = pack8(S0, 0); pk1 = pack8(S0, 1);
#pragma unroll
    for (int i = 0; i < 8; ++i) { S1[i] = __builtin_amdgcn_exp2f(S1[i]); ls += S1[i]; }
    SB();
    __builtin_amdgcn_s_setprio(1);
    b_pv(o, f0, pk0);
    b_vfrag(f1, vb, trb, 1);
#pragma unroll
    for (int i = 8; i < 16; ++i) { S1[i] = __builtin_amdgcn_exp2f(S1[i]); ls += S1[i]; }
    SB();
    b_pv(o, f1, pk1);
    b_vfrag(f0, vb, trb, 2);
    pk2 = pack8(S1, 0); pk3 = pack8(S1, 1);
    lrun += ls;
    SB();
    b_pv(o, f0, pk2);
    b_vfrag(f1, vb, trb, 3);
    float mx = a_rowmax(N0, N1); mx = hasN ? mx : -1e30f;
    SB();
    b_pv(o, f1, pk3);
    __builtin_amdgcn_s_setprio(0);
    SB();
    if (__any(mx > 8.f)) {
        const float dl = fmaxf(mx, 0.f), al = __builtin_amdgcn_exp2f(-dl);
        lrun *= al;
#pragma unroll
        for (int i = 0; i < 4; ++i)
#pragma unroll
            for (int j = 0; j < 16; ++j) o[i][j] *= al;
#pragma unroll
        for (int j = 0; j < 16; ++j) { N0[j] -= dl; N1[j] -= dl; negm[j] -= dl; }
    }
    __syncthreads();
}
DI void a_unit_bf(const AttnCtx& c, ldsp lds, int wave, int lane, int mm, f32x16 (&o)[4], const bf16x8 (&qr)[4], float& mrun, float& lrun) {
    const int r = lane & 31, h = lane >> 5, q = (lane & 15) >> 2, pp = lane & 3, g16 = (lane >> 4) & 1;
    int trb[4];
#pragma unroll
    for (int db = 0; db < 4; ++db) trb[db] = (4 * h + q) * 256 + (4 * (db ^ q) + 2 * g16 + (pp >> 1)) * 16 + 8 * (pp & 1);
    AttnCtx cc = c; cc.koff = r * 256 + (((8 * mm + h) ^ (r & 15)) * 16);
    a_dma_tile(lds + B_K0, c.KB, c.kbase, c.kvh, wave, lane, false);
    a_dma_tile(lds + B_V0, c.VB2, c.kbase, c.kvh, wave, lane, true);
    a_dma_tile(lds + B_K0 + B_TS, c.KB, c.kbase + min(1, c.nt - 1) * 64, c.kvh, wave, lane, false);
    __syncthreads();
    f32x16 A0, A1, B0, B1, negm;
    b_qk(A0, A1, lds + B_K0, cc.koff, qr, zero16());
    mrun = a_rowmax(A0, A1); lrun = 0.f;
#pragma unroll
    for (int j = 0; j < 16; ++j) { A0[j] -= mrun; A1[j] -= mrun; negm[j] = -mrun; }
    for (int t = 0; t < c.nt; t += 2) {
        b_step(cc, lds, wave, lane, t, A0, A1, B0, B1, o, qr, trb, negm, lrun);
        if (t + 1 < c.nt) b_step(cc, lds, wave, lane, t + 1, B0, B1, A0, A1, o, qr, trb, negm, lrun);
    }
}
DI void attn_phase(const Params& p, ldsp lds, int tid0, int lane0, int wave) {
    unsigned char* ws = p.ws;
    const bf16_t* QB2 = (const bf16_t*)(ws + WS_QB); bf16_t* OB = (bf16_t*)(ws + WS_OB);
    unsigned* qhead = (unsigned*)(ws + WS_CTL);
    const int th = wave & 1, g = (wave >> 1) & 1, mm = wave >> 2;
    const int x = blockIdx.x & 7;
    float lam;
    { const float a = p.in[I_LQ1][lane0] * p.in[I_LK1][lane0], b = p.in[I_LQ2][lane0] * p.in[I_LK2][lane0]; lam = __expf(wave_sum(a)) - __expf(wave_sum(b)) + LAM_INIT; }
    for (;;) {
        int lane = lane0; asm volatile("" : "+v"(lane));
        const int tid = (wave << 6) | lane, r = lane & 31, h = lane >> 5;
        AttnCtx c; c.tid = tid; c.h = h; c.KB = (const bf16_t*)(ws + WS_KB); c.VB2 = (const bf16_t*)(ws + WS_VB2); c.koff = 0; c.tr_off = 0;
        if (tid == 0) *(LAS unsigned*)(lds + A_ITEM) = __hip_atomic_fetch_add(qhead + x * 64, 1u, __ATOMIC_RELAXED, __HIP_MEMORY_SCOPE_AGENT);
        __syncthreads();
        const int item = (int)*(LAS unsigned*)(lds + A_ITEM);
        if (item >= 16 + 256) break;
        int qrow0; bool fp;
        if (item < 16) { c.bs = x * 4 + (item >> 2); c.kvh = item & 3; qrow0 = MP + c.bs * 64; c.kbase = qrow0; fp = true; c.nt = 65; }
        else { const int b = x >> 2, qc = 255 - (item - 16); c.bs = 0; c.kvh = x & 3; qrow0 = b * 16384 + qc * 64; c.kbase = b * 16384; fp = false; c.nt = qc + 1; }
        c.ckp = p.in[I_CK] + ((size_t)c.bs * 4096 * 4 + c.kvh) * 128; c.cvp = p.in[I_CV] + ((size_t)c.bs * 4096 * 4 + c.kvh) * 128;
        const int hq = c.kvh * 2 + g;
        bf16x8 qr[4];
        { const bf16_t* qp = QB2 + (size_t)(qrow0 + 32 * th + r) * 1024 + hq * 128 + mm * 64 + 8 * h;
#pragma unroll
          for (int d0 = 0; d0 < 4; ++d0) qr[d0] = *(const bf16x8*)(qp + 16 * d0); }
        f32x16 o[4];
#pragma unroll
        for (int i = 0; i < 4; ++i) o[i] = zero16();
        float mrun, lrun;
        if (fp) a_unit_fp(p, c, lds, o, qr, mrun, lrun, mm, lane); else a_unit_bf(c, lds, wave, lane, mm, o, qr, mrun, lrun);
        lrun += __shfl_xor(lrun, 32);
        const float inv = __builtin_amdgcn_rcpf(lrun);
        LAS float* cmb = (LAS float*)(lds) + (size_t)(g * 2 + th) * 4096 + lane;
        if (mm == 1) {
            const float sc = lam * inv;
#pragma unroll
            for (int i = 0; i < 4; ++i)
#pragma unroll
                for (int j = 0; j < 16; ++j) cmb[(i * 16 + j) * 64] = o[i][j] * sc;
        }
        __syncthreads();
        if (mm == 0) {
            float ssq = 0.f;
#pragma unroll
            for (int i = 0; i < 4; ++i)
#pragma unroll
                for (int j = 0; j < 16; ++j) { const float v = o[i][j] * inv - cmb[(i * 16 + j) * 64]; o[i][j] = v; ssq += v * v; }
            ssq += __shfl_xor(ssq, 32);
            const float rn = rsqrtf(ssq * (1.f / 128.f) + EPS) * (1.f - LAM_INIT);
            bf16_t* op = OB + (size_t)(qrow0 + 32 * th + r) * 1024 + hq * 128;
#pragma unroll
            for (int i = 0; i < 4; ++i)
#pragma unroll
                for (int g4 = 0; g4 < 4; ++g4) { const int dv0 = 32 * i + 8 * g4 + 4 * h; const f32x4 gg = *(const f32x4*)(p.in[I_SUBLN] + dv0);
                    u32x2 w; w.x = pk2(o[i][4 * g4] * rn * gg.x, o[i][4 * g4 + 1] * rn * gg.y); w.y = pk2(o[i][4 * g4 + 2] * rn * gg.z, o[i][4 * g4 + 3] * rn * gg.w);
                    *(u32x2*)(op + dv0) = w; }
        }
        __syncthreads();
    }
}

#define XB_TMO      128
#define XB_XCNT(j)  (256  + 64 * (j))
#define XB_XSUB(j)  (1280 + 64 * (j))
#define XB_XGEN(j)  (2304 + 64 * (j))
#define XB_TOP      3328
#define XB_TOPGEN   3392
#define XCD_BAR_WORDS 3456
#define XB_SPIN_CAP (1u << 18)

__device__ __forceinline__ unsigned xb_ld(unsigned* p)              { return __hip_atomic_load(p, __ATOMIC_RELAXED, __HIP_MEMORY_SCOPE_AGENT); }
__device__ __forceinline__ unsigned xb_add(unsigned* p, unsigned v) { return __hip_atomic_fetch_add(p, v, __ATOMIC_RELAXED, __HIP_MEMORY_SCOPE_AGENT); }
__device__ __forceinline__ unsigned xb_xcc_id() { return (unsigned)__builtin_amdgcn_s_getreg((3 << 11) | 20) & 0xFu; }
#define XB_SPIN(cond, bar) do { unsigned _sp = 0; while (cond) { __builtin_amdgcn_s_sleep(1); \
    if ((++_sp & 255u) == 0u) { if (xb_ld(&(bar)[XB_TMO])) break; if (_sp > XB_SPIN_CAP) { atomicAdd(&(bar)[XB_TMO], 1u); break; } } } } while (0)

struct XcdBarrier {
    unsigned* bar; unsigned x;
    volatile LAS unsigned* st;
};

__device__ __forceinline__ XcdBarrier xcd_barrier_post(unsigned* bar, volatile LAS unsigned* st) {
    XcdBarrier b; b.bar = bar; b.x = xb_xcc_id(); b.st = st;
    if (threadIdx.x == 0) (void)xb_add(&bar[XB_XCNT(b.x)], 1u);
    return b;
}
__device__ __forceinline__ void xcd_barrier_complete(unsigned* bar, unsigned x, unsigned& nloc, unsigned& nx) {
    const unsigned G = gridDim.x * gridDim.y * gridDim.z;
    unsigned sum, cnt, mine, sp = 0u;
    for (;;) {
        sum = 0u; cnt = 0u; mine = 0u;
#pragma unroll
        for (unsigned j = 0; j < 16; ++j) { const unsigned c = xb_ld(&bar[XB_XCNT(j)]); sum += c; cnt += (c > 0u) ? 1u : 0u; mine = (j == x) ? c : mine; }
        if (sum == G) break;
        __builtin_amdgcn_s_sleep(1);
        if ((++sp & 255u) == 0u) { if (xb_ld(&bar[XB_TMO])) break; if (sp > XB_SPIN_CAP) { atomicAdd(&bar[XB_TMO], 1u); break; } }
    }
    nloc = mine > 0u ? mine : 1u; nx = cnt > 0u ? cnt : 1u;
}

__device__ __forceinline__ void xcd_barrier(const XcdBarrier& b) {
    asm volatile("s_waitcnt vmcnt(0)" ::: "memory");
    __syncthreads();
    if (threadIdx.x == 0) {
        unsigned* bar = b.bar;
        __builtin_amdgcn_s_waitcnt(0);
        unsigned nloc = b.st[0], nx = b.st[1];
        if (nloc == 0u) { xcd_barrier_complete(bar, b.x, nloc, nx); b.st[0] = nloc; b.st[1] = nx; }
        const unsigned old = xb_add(&bar[XB_XSUB(b.x)], 1u);
        const unsigned gen = old / nloc;
        if (old + 1u == (gen + 1u) * nloc) {
            __builtin_amdgcn_fence(__ATOMIC_RELEASE, "agent");
            asm volatile("s_waitcnt vmcnt(0)" ::: "memory");
            const unsigned og = xb_add(&bar[XB_TOP], 1u);
            const unsigned tg = og / nx;
            if (og + 1u == (tg + 1u) * nx) xb_add(&bar[XB_TOPGEN], 1u);
            else XB_SPIN(xb_ld(&bar[XB_TOPGEN]) == tg, bar);
            __builtin_amdgcn_fence(__ATOMIC_ACQUIRE, "agent");
            xb_add(&bar[XB_XGEN(b.x)], 1u);
            asm volatile("s_waitcnt vmcnt(0)" ::: "memory");
        } else {
            XB_SPIN(xb_ld(&bar[XB_XGEN(b.x)]) == gen, bar);
            __builtin_amdgcn_fence(__ATOMIC_ACQUIRE, "agent");
            asm volatile("s_waitcnt vmcnt(0)" ::: "memory");
        }
    }
    __syncthreads();
}

struct SplitSched {
    int G, c;
    DI bool next(int i, Unit& u) const { const int L = i * G + c; if (L >= 256) return false; u.ko = (L & 7); u.pn = (L >> 3) & 3; u.pm = 128 + (L >> 5); return true; }
    DI void a_ready(const Unit&) const {}
    DI void done(const Unit&) const {}
};
struct EpiPart {
    static constexpr bool PERM = true, AFTER_DRAIN = false;
    float* PART; int kslice;
    DI void operator()(const f32x4 (&acc)[2][2][4][2], const Unit& u, int wr, int wc, int fr, int fq) const {
        const int cbase = u.pn * 256 + wc * 32 + 8 * fq; float* base = PART + (size_t)(u.ko / kslice) * 2048 * 1024;
#pragma unroll
        for (int ai = 0; ai < 2; ++ai)
#pragma unroll
            for (int m = 0; m < 4; ++m) {
                const int row = (u.pm - 128) * 256 + ai * 128 + wr * 64 + m * 16 + fr;
#pragma unroll
                for (int bj = 0; bj < 2; ++bj) { float* o = base + (size_t)row * 1024 + cbase + bj * 128; *(f32x4*)o = acc[ai][bj][m][0]; *(f32x4*)(o + 4) = acc[ai][bj][m][1]; }
            }
    }
};
struct SplitSchedK {
    int G, c, kslice;
    DI bool next(int i, Unit& u) const { const int L = i * G + c; if (L >= 256) return false; u.ko = (L & 7) * kslice; u.pn = (L >> 3) & 3; u.pm = 128 + (L >> 5); return true; }
    DI void a_ready(const Unit&) const {}
    DI void done(const Unit&) const {}
};
DI void run_gemm_mix(ldsp lds, unsigned char* ws, const bf16_t* A, const bf16_t* Bt, int K) {
    { pg8::Gemm g{A, Bt, MP, 1024, K, K}; pg8::StaticOrder S; S.init(MP, 1024, (int)gridDim.x, (int)blockIdx.x); EpiMix E{ws};
      pg8::gemm_phase<EpiMix, pg8::StaticOrder, true, true>(lds, g, S, E); }
    { pg8::Gemm g{A, Bt, M, 1024, K / 8, K}; SplitSchedK S{(int)gridDim.x, (int)blockIdx.x, K / 8}; EpiPart E{(float*)(ws + WS_QB), K / 8};
      pg8::gemm_phase<EpiPart, SplitSchedK, false, true>(lds, g, S, E); }
}
template <class Epi> DI void run_gemm(ldsp lds, const bf16_t* A, const bf16_t* Bt, int N, int K, const Epi& E) {
    pg8::Gemm g{A, Bt, M, N, K, K}; pg8::StaticOrder S; S.init(M, N, (int)gridDim.x, (int)blockIdx.x);
    pg8::gemm_phase<Epi, pg8::StaticOrder, true, true>(lds, g, S, E);
}
#ifndef MK_LAST_PHASE
#define MK_LAST_PHASE 99
#endif
__global__ void __launch_bounds__(512, 2) yoco_fwd(Params p) {
    extern __shared__ __attribute__((aligned(16))) unsigned char lds_raw[];
    cg::grid_group grid = cg::this_grid();
    ldsp lds = (ldsp)lds_raw;
    const int tid = threadIdx.x, lane = tid & 63, wave = __builtin_amdgcn_readfirstlane(tid >> 6);
    unsigned char* ws = p.ws;
    float* RINV = (float*)(ws + WS_RINV); bf16_t* XB = (bf16_t*)(ws + WS_XB); bf16_t* MIXB = (bf16_t*)(ws + WS_MIXB); bf16_t* OB = (bf16_t*)(ws + WS_OB); bf16_t* HB = (bf16_t*)(ws + WS_HB);
#define SEAM(k) xcd_barrier(bar)
#define PH(k) ((p.mask >> (k)) & 1u)
    volatile LAS unsigned* xst = (volatile LAS unsigned*)(lds + 147200);
    if (tid < 2) xst[tid] = 0u;
    phase0(p, lds, tid, lane, wave, PH(0));
    grid.sync();
    XcdBarrier bar = xcd_barrier_post((unsigned*)(ws + WS_CTL) + 4096, xst);
    if (PH(1)) { EpiIn E{ws, p.in[I_LB]}; run_gemm(lds, XB, (const bf16_t*)(ws + WS_WIN), 4096, 1024, E); }
    SEAM(1);
    if (PH(2)) hgrn_a(p, lds, tid, lane, wave);
    SEAM(2);
    if (PH(4)) hgrn_c(p, lds, tid, lane, wave);
    SEAM(4);
    if (PH(5)) run_gemm_mix(lds, ws, OB, (const bf16_t*)(ws + WS_WOA), 1024);
    SEAM(5);
    if (PH(6)) thin_phase<false, false>(p, p.in[I_NMIXPOST], lane, wave);
    SEAM(6);
    if (PH(7)) { EpiUp E{ws}; run_gemm(lds, XB, (const bf16_t*)(ws + WS_WUP0), 4096, 1024, E); }
    SEAM(7);
    if (PH(8)) run_gemm_mix(lds, ws, HB, (const bf16_t*)(ws + WS_WDN0), 4096);
    SEAM(8);
    if (PH(9)) thin_phase<false, false>(p, p.in[I_NMLPPOST], lane, wave);
    SEAM(9);
    if (PH(10)) { EpiKvq E{ws, p.out}; run_gemm(lds, XB, (const bf16_t*)(ws + WS_WKVQ), 2048, 1024, E); }
    SEAM(10);
    if (PH(11)) attn_phase(p, lds, tid, lane, wave);
    SEAM(11);
    if (PH(12)) run_gemm_mix(lds, ws, OB, (const bf16_t*)(ws + WS_WOB), 1024);
    SEAM(12);
    if (PH(13)) thin_phase<false, false>(p, p.in[I_NMIXPOST] + 1024, lane, wave);
    SEAM(13);
    if (PH(14)) { EpiUp E{ws}; run_gemm(lds, XB, (const bf16_t*)(ws + WS_WUP1), 4096, 1024, E); }
    SEAM(14);
    if (PH(15)) run_gemm_mix(lds, ws, HB, (const bf16_t*)(ws + WS_WDN1), 4096);
    SEAM(15);
    if (PH(16)) thin_phase<false, true>(p, p.in[I_NMLPPOST] + 1024, lane, wave);
#undef PH
#undef SEAM
}
}

extern "C" void kernel_launch(void* const* d_in, const int* in_sizes, int n_in, void* d_out, int out_size, void* d_ws, size_t ws_size, hipStream_t stream) {
    static int grid = 0;
    if (grid == 0) {
        if (n_in != 24 || ws_size < mk::WS_END) { fprintf(stderr, "kernel_launch: need 24 inputs and >= %zu bytes of workspace; got %d, %zu\n", (size_t)mk::WS_END, n_in, ws_size); grid = -1; return; }
        int dev = 0, cus = 0, per_cu = 0;
        if (hipGetDevice(&dev) != hipSuccess || hipDeviceGetAttribute(&cus, hipDeviceAttributeMultiprocessorCount, dev) != hipSuccess) { grid = -1; return; }
        if (hipFuncSetAttribute((const void*)mk::yoco_fwd, hipFuncAttributeMaxDynamicSharedMemorySize, mk::LDS_BYTES) != hipSuccess) { fprintf(stderr, "kernel_launch: hipFuncSetAttribute failed\n"); grid = -1; return; }
        if (hipOccupancyMaxActiveBlocksPerMultiprocessor(&per_cu, (const void*)mk::yoco_fwd, 512, mk::LDS_BYTES) != hipSuccess || per_cu < 1) { fprintf(stderr, "kernel_launch: occupancy query says %d\n", per_cu); per_cu = 1; }
        (void)hipGetLastError();
        grid = cus;
    }
    if (grid < 0) return;
    mk::Params prm{};
    for (int i = 0; i < 24; ++i) prm.in[i] = (const float*)d_in[i];
    prm.out = (float*)d_out; prm.ws = (unsigned char*)d_ws;
#if defined(MK_PROBE_MASK)
    { prm.mask = MK_PROBE_MASK; void* pa[] = {&prm}; (void)hipLaunchCooperativeKernel((const void*)mk::yoco_fwd, dim3(grid), dim3(512), pa, mk::LDS_BYTES, stream); }
#endif
    prm.mask = 0x1ffffu;
    void* args[] = {&prm};
    hipError_t e = hipLaunchCooperativeKernel((const void*)mk::yoco_fwd, dim3(grid), dim3(512), args, mk::LDS_BYTES, stream);
    if (e != hipSuccess) fprintf(stderr, "kernel_launch: cooperative launch failed: %s (grid %d)\n", hipGetErrorString(e), grid);
}
```

```cpp
#include <hip/hip_runtime.h>
#include <hip/hip_cooperative_groups.h>
#include <cstdio>
#include <cstdint>
namespace cg = cooperative_groups;

namespace pg8 {
#define PG8_LAS __attribute__((address_space(3)))
typedef unsigned short bf16_t;
typedef short bf16x8 __attribute__((ext_vector_type(8)));
typedef float f32x4 __attribute__((ext_vector_type(4)));
typedef unsigned u32x4 __attribute__((ext_vector_type(4)));
constexpr int BM = 256, BK = 64, HALF = 128, HTB = HALF * BK * 2  , STAGE_BYTES = 8 * HTB, NXCD = 8, WGM = 8;

__host__ __device__ __forceinline__ int lds_byte(int r, int c) { const int st = (r >> 4) * 2 + (c >> 5), rr = r & 15, cc = c & 31, ob = rr * 64 + cc * 2; return st * 1024 + (ob ^ (((ob >> 9) & 1) << 5)); }
__host__ __device__ __forceinline__ void stage_rc(int b, int& R, int& C) { const int st = b / 1024, sb = b % 1024, swz = sb ^ (((sb >> 9) & 1) << 5); R = (st >> 1) * 16 + swz / 64; C = (st & 1) * 32 + (swz % 64) / 2; }
__host__ __device__ __forceinline__ int perm32(int rho) { const int n = rho >> 4, i = rho & 15; return 8 * (i >> 2) + 4 * n + (i & 3); }

struct Unit { int pm, pn, ko; };
struct Gemm { const bf16_t* A; const bf16_t* Bt; int M, N, K, ld; };

struct StaticOrder {
    int nM, nN, nwg, G, c;
    __host__ __device__ void init(int M, int N, int G_, int c_) { nM = M / BM; nN = N / BM; nwg = nM * nN; G = G_; c = c_; }
    __host__ __device__ bool next(int i, Unit& u) const {
        const long L = (long)i * G + c; if (L >= nwg) return false;
        int wgid = (int)L; { const int q = nwg / NXCD, r = nwg % NXCD, xcd = wgid % NXCD, off = wgid / NXCD; wgid = (xcd < r ? xcd * (q + 1) : r * (q + 1) + (xcd - r) * q) + off; }
        const int nig = WGM * nN, gid = wgid / nig, fm = gid * WGM, gsz = (nM - fm) < WGM ? (nM - fm) : WGM;
        u.pm = fm + ((wgid % nig) % gsz); u.pn = (wgid % nig) / gsz; u.ko = 0; return true;
    }
    __device__ __forceinline__ void a_ready(const Unit&) const {}
    __device__ __forceinline__ void done(const Unit&) const {}
};

__device__ __forceinline__ unsigned cvt_pk_bf16(float lo, float hi) { unsigned r; asm volatile("v_cvt_pk_bf16_f32 %0, %1, %2" : "=v"(r) : "v"(lo), "v"(hi)); return r; }
template <class Epi, class Sched, bool ALIGN_EPI = false, bool SP2 = false>
__device__ __forceinline__ void gemm_phase(PG8_LAS unsigned char* lds, const Gemm g, const Sched& S, const Epi& E) {
    int tid = threadIdx.x; asm volatile("" : "+v"(tid));
    const int wid = __builtin_amdgcn_readfirstlane(tid >> 6), lane = tid & 63, wr = wid >> 2, wc = wid & 3, fr = lane & 15, fq = lane >> 4;
    const int K = g.K, nt = K / BK;
    unsigned voffA[2], voffB[2];
#pragma unroll
    for (int i = 0; i < 2; ++i) { int R, C; stage_rc(tid * 16 + i * 8192, R, C); const int Rb = Epi::PERM ? ((R & ~31) + perm32(R & 31)) : R;
        voffA[i] = (unsigned)(R * g.ld + C) * 2u; voffB[i] = (unsigned)(Rb * g.ld + C) * 2u; }
    const size_t kstep = (size_t)(BK * 2);
    const size_t hstep = (size_t)HALF * g.ld * 2;
    const size_t tstep = 2 * hstep;
    const unsigned ldsw = (unsigned)wid * 1024u;
    const int aoff = lds_byte(wr * 64 + fr, fq * 8), boff = lds_byte(wc * 32 + fr, fq * 8);
#define PG8_SA(b, h) (((b) * 2 + (h)) * HTB)
#define PG8_SB(b, h) ((4 + (b) * 2 + (h)) * HTB)
#define PG8_STAGE(bufoff, gbase, voff) do { _Pragma("unroll") for (int _i = 0; _i < 2; ++_i) \
        __builtin_amdgcn_global_load_lds((const unsigned*)((const char*)(gbase) + (voff)[_i]), (PG8_LAS unsigned*)(lds + (bufoff) + ldsw + _i * 8192), 16, 0, 0); } while (0)
#define PG8_LDA(dst, b, h) do { _Pragma("unroll") for (int m = 0; m < 4; ++m) _Pragma("unroll") for (int k = 0; k < 2; ++k) dst[m][k] = *(const PG8_LAS bf16x8*)(lds + PG8_SA(b, h) + aoff + m * 2048 + k * 1024); } while (0)
#define PG8_LDB(dst, b, h) do { _Pragma("unroll") for (int n = 0; n < 2; ++n) _Pragma("unroll") for (int k = 0; k < 2; ++k) dst[n][k] = *(const PG8_LAS bf16x8*)(lds + PG8_SB(b, h) + boff + n * 2048 + k * 1024); } while (0)
#define PG8_MMA(ai, bj, At, Bt) do { __builtin_amdgcn_s_setprio(1); _Pragma("unroll") for (int m = 0; m < 4; ++m) _Pragma("unroll") for (int n = 0; n < 2; ++n) _Pragma("unroll") for (int k = 0; k < 2; ++k) \
        acc[ai][bj][m][n] = __builtin_amdgcn_mfma_f32_16x16x32_bf16(Bt[n][k], At[m][k], acc[ai][bj][m][n], 0, 0, 0); __builtin_amdgcn_s_setprio(0); } while (0)
#define PG8_WAIT_V(n) asm volatile("s_waitcnt vmcnt(" #n ")" ::: "memory")
#define PG8_WAIT_L(n) asm volatile("s_waitcnt lgkmcnt(" #n ")" ::: "memory")
#define PG8_BAR __builtin_amdgcn_s_barrier()
#define PG8_SCHED __builtin_amdgcn_sched_barrier(0)
    Unit cur, nxt; int ui = 0;
    if (!S.next(0, cur)) return;
    f32x4 acc[2][2][4][2];
#pragma unroll
    for (int a = 0; a < 2; ++a)
#pragma unroll
        for (int b = 0; b < 2; ++b)
#pragma unroll
            for (int m = 0; m < 4; ++m)
#pragma unroll
                for (int n = 0; n < 2; ++n) acc[a][b][m][n] = (f32x4){0.f, 0.f, 0.f, 0.f};
    bf16x8 At[4][2], B0[2][2], B1[2][2];
    const char* cA = (const char*)g.A + (size_t)cur.pm * tstep + (size_t)cur.ko * 2; const char* cB = (const char*)g.Bt + (size_t)cur.pn * tstep + (size_t)cur.ko * 2;
    S.a_ready(cur);
    if constexpr (SP2) {
        PG8_STAGE(PG8_SB(0, 0), cB, voffB); PG8_STAGE(PG8_SB(0, 1), cB + hstep, voffB); PG8_STAGE(PG8_SA(0, 0), cA, voffA); PG8_STAGE(PG8_SA(0, 1), cA + hstep, voffA);
        if (wr == 1) PG8_BAR;
        PG8_WAIT_V(2); PG8_BAR;
        PG8_STAGE(PG8_SB(1, 0), cB + kstep, voffB); PG8_STAGE(PG8_SA(1, 0), cA + kstep, voffA); PG8_STAGE(PG8_SB(1, 1), cB + hstep + kstep, voffB);
        PG8_WAIT_V(6); PG8_BAR;
    } else {
        PG8_STAGE(PG8_SB(0, 0), cB, voffB); PG8_STAGE(PG8_SA(0, 0), cA, voffA); PG8_STAGE(PG8_SB(0, 1), cB + hstep, voffB); PG8_STAGE(PG8_SA(0, 1), cA + hstep, voffA);
        if (wr == 1) PG8_BAR;
        PG8_WAIT_V(4); PG8_BAR;
        PG8_STAGE(PG8_SB(1, 0), cB + kstep, voffB); PG8_STAGE(PG8_SA(1, 0), cA + kstep, voffA); PG8_STAGE(PG8_SB(1, 1), cB + hstep + kstep, voffB);
        PG8_WAIT_V(6); PG8_BAR;
    }
    for (;;) {
        const bool has_next = S.next(ui + 1, nxt);
        const char* nA = has_next ? (const char*)g.A + (size_t)nxt.pm * tstep + (size_t)nxt.ko * 2 : cA; const char* nB = has_next ? (const char*)g.Bt + (size_t)nxt.pn * tstep + (size_t)nxt.ko * 2 : cB;
        for (int t = 0; t < nt; t += 2) {
            const bool last = (t == nt - 2);
            const char* a1 = cA + (size_t)(t + 1) * kstep;
            const char* a2 = last ? nA : cA + (size_t)(t + 2) * kstep; const char* b2 = last ? nB : cB + (size_t)(t + 2) * kstep;
            const char* a3 = a2 + kstep; const char* b3 = b2 + kstep;
            if (last && has_next) S.a_ready(nxt);
            if constexpr (SP2) {
            PG8_LDB(B0, 0, 0); PG8_LDB(B1, 0, 1); PG8_SCHED; PG8_LDA(At, 0, 0); PG8_STAGE(PG8_SA(1, 1), a1 + hstep, voffA);
            PG8_WAIT_V(8); PG8_WAIT_L(0); PG8_BAR; PG8_MMA(0, 0, At, B0); PG8_MMA(0, 1, At, B1); PG8_BAR; PG8_SCHED;
            PG8_LDA(At, 0, 1); PG8_STAGE(PG8_SB(0, 0), b2, voffB); PG8_STAGE(PG8_SB(0, 1), b2 + hstep, voffB); PG8_STAGE(PG8_SA(0, 0), a2, voffA);
            PG8_WAIT_V(8); PG8_WAIT_L(0); PG8_BAR; PG8_MMA(1, 0, At, B0); PG8_MMA(1, 1, At, B1); PG8_BAR; PG8_SCHED;
            PG8_LDB(B0, 1, 0); PG8_LDB(B1, 1, 1); PG8_SCHED; PG8_LDA(At, 1, 0); PG8_STAGE(PG8_SA(0, 1), a2 + hstep, voffA);
            PG8_WAIT_V(8); PG8_WAIT_L(0); PG8_BAR; PG8_MMA(0, 0, At, B0); PG8_MMA(0, 1, At, B1); PG8_BAR; PG8_SCHED;
            PG8_LDA(At, 1, 1); PG8_STAGE(PG8_SB(1, 0), b3, voffB); PG8_STAGE(PG8_SB(1, 1), b3 + hstep, voffB); PG8_STAGE(PG8_SA(1, 0), a3, voffA);
            PG8_WAIT_V(8); PG8_WAIT_L(0); PG8_BAR; PG8_MMA(1, 0, At, B0); PG8_MMA(1, 1, At, B1); PG8_BAR; PG8_SCHED;
            } else {
            PG8_LDB(B0, 0, 0); PG8_SCHED; PG8_LDA(At, 0, 0); PG8_STAGE(PG8_SA(1, 1), a1 + hstep, voffA);
            PG8_WAIT_L(8); PG8_BAR; PG8_WAIT_L(0); PG8_MMA(0, 0, At, B0); PG8_BAR; PG8_SCHED;
            PG8_LDB(B1, 0, 1); PG8_STAGE(PG8_SB(0, 0), b2, voffB);
            PG8_BAR; PG8_WAIT_L(0); PG8_MMA(0, 1, At, B1); PG8_BAR;
            PG8_LDA(At, 0, 1); PG8_STAGE(PG8_SA(0, 0), a2, voffA);
            PG8_BAR; PG8_WAIT_L(0); PG8_MMA(1, 0, At, B0); PG8_BAR; PG8_SCHED;
            PG8_STAGE(PG8_SB(0, 1), b2 + hstep, voffB);
            PG8_WAIT_V(6); PG8_BAR; PG8_MMA(1, 1, At, B1); PG8_BAR;
            PG8_LDB(B0, 1, 0); PG8_SCHED; PG8_LDA(At, 1, 0); PG8_STAGE(PG8_SA(0, 1), a2 + hstep, voffA);
            PG8_WAIT_L(8); PG8_BAR; PG8_WAIT_L(0); PG8_MMA(0, 0, At, B0); PG8_BAR; PG8_SCHED;
            PG8_LDB(B1, 1, 1); PG8_STAGE(PG8_SB(1, 0), b3, voffB);
            PG8_BAR; PG8_WAIT_L(0); PG8_MMA(0, 1, At, B1); PG8_BAR;
            PG8_LDA(At, 1, 1); PG8_STAGE(PG8_SA(1, 0), a3, voffA);
            PG8_BAR; PG8_WAIT_L(0); PG8_MMA(1, 0, At, B0); PG8_BAR; PG8_SCHED;
            PG8_STAGE(PG8_SB(1, 1), b3 + hstep, voffB);
            PG8_WAIT_V(6); PG8_BAR; PG8_MMA(1, 1, At, B1); PG8_BAR;
            }
        }
        if constexpr (ALIGN_EPI) { if (wr == 0) PG8_BAR; }
        if constexpr (!Epi::AFTER_DRAIN) { E(acc, cur, wr, wc, fr, fq); S.done(cur); }
        if (!has_next) break;
#pragma unroll
        for (int a = 0; a < 2; ++a)
#pragma unroll
            for (int b = 0; b < 2; ++b)
#pragma unroll
                for (int m = 0; m < 4; ++m)
#pragma unroll
                    for (int n = 0; n < 2; ++n) acc[a][b][m][n] = (f32x4){0.f, 0.f, 0.f, 0.f};
        cur = nxt; cA = nA; cB = nB; ++ui;
        if constexpr (ALIGN_EPI) { if (wr == 1) PG8_BAR; }
    }
    PG8_WAIT_V(0);
    if constexpr (!ALIGN_EPI) { if (wr == 0) PG8_BAR; }
    PG8_BAR;
    if constexpr (Epi::AFTER_DRAIN) { E.fused(acc, cur, wr, wc, fr, fq, lds, wid, lane); S.done(cur); }
#undef PG8_SA
#undef PG8_SB
#undef PG8_STAGE
#undef PG8_LDA
#undef PG8_LDB
#undef PG8_MMA
#undef PG8_WAIT_V
#undef PG8_WAIT_L
#undef PG8_BAR
#undef PG8_SCHED
}
}

namespace mk {
using pg8::bf16_t; using pg8::f32x4; using pg8::u32x4; using pg8::bf16x8; using pg8::Unit;
typedef float f32x16 __attribute__((ext_vector_type(16)));
typedef float f32x2 __attribute__((ext_vector_type(2)));
typedef unsigned u32x2 __attribute__((ext_vector_type(2)));
typedef short s16x4 __attribute__((ext_vector_type(4)));
#define DI __device__ __forceinline__
#define LAS __attribute__((address_space(3)))
typedef LAS unsigned char* ldsp;

constexpr int M = 34816, MP = 32768, D = 1024, FF = 4096, NCHUNK = 544, NCHP = 512;
constexpr float EPS = 1e-6f;
constexpr float LAM_INIT = 0.35550906759096934f;
constexpr float QSCALE = 0.18033688011112042f;
constexpr float QA_SCALE = 0.08838834764831845f;
constexpr size_t O_Y = 0, O_SP = 35651584, O_KP = 35913728, O_VP = 52690944, O_SS = 69468160, O_KS = 73662464, O_VS = 74711040;
constexpr size_t MiB = 1u << 20;
constexpr size_t WS_CTL = 0, WS_WIN = 2 * MiB, WS_WOA = 10 * MiB, WS_WUP0 = 12 * MiB, WS_WDN0 = 20 * MiB, WS_WKVQ = 28 * MiB, WS_WOB = 32 * MiB, WS_WUP1 = 34 * MiB, WS_WDN1 = 42 * MiB;
constexpr size_t WS_COS = 50 * MiB, WS_SIN = 50 * MiB + 512 * 1024, WS_RINV = 51 * MiB, WS_DEC = 52 * MiB;
constexpr size_t WS_XB = 56 * MiB, WS_QB = 124 * MiB, WS_VB = 192 * MiB, WS_KB = 192 * MiB, WS_VB2 = 226 * MiB, WS_GATE = 260 * MiB, WS_MIXB = 260 * MiB;
constexpr size_t WS_G = 328 * MiB, WS_UT = 464 * MiB, WS_HB = 328 * MiB, WS_OB = 600 * MiB, WS_END = 720 * MiB;
constexpr int LDS_BYTES = 147456;

struct Params { const float* in[24]; float* out; unsigned char* ws; unsigned mask; unsigned pad; };
enum { I_XP = 0, I_XS, I_STATE, I_CK, I_CV, I_NMIXPRE, I_NMIXPOST, I_NMLPPRE, I_NMLPPOST, I_WUP, I_WDOWN, I_WIN, I_LB, I_GNORM, I_WOA, I_NKV, I_WKV, I_WQ, I_LQ1, I_LK1, I_LQ2, I_LK2, I_SUBLN, I_WOB };

DI unsigned pk2(float lo, float hi) { typedef __bf16 bf2 __attribute__((ext_vector_type(2))); f32x2 v = {lo, hi}; bf2 b = __builtin_convertvector(v, bf2); return __builtin_bit_cast(unsigned, b); }
DI float bflo(unsigned w) { return __uint_as_float(w << 16); }
DI float bfhi(unsigned w) { return __uint_as_float(w & 0xffff0000u); }
DI float bf2f(unsigned short u) { return __uint_as_float((unsigned)u << 16); }
DI unsigned short f2bf(float f) { return (unsigned short)(pk2(f, 0.f) & 0xffffu); }
DI float wave_sum(float v) {
#pragma unroll
    for (int o = 1; o < 64; o <<= 1) v += __shfl_xor(v, o);
    return v;
}
DI float fsigmoid(float x) { return __builtin_amdgcn_rcpf(1.f + __expf(-x)); }
DI float fsilu(float x) { return x * fsigmoid(x); }
DI int crow(int r, int hi) { return (r & 3) + 8 * (r >> 2) + 4 * hi; }
#define LDS_WAIT() asm volatile("s_waitcnt lgkmcnt(0)" ::: "memory")
DI f32x16 mfma32(bf16x8 a, bf16x8 b, f32x16 c) { return __builtin_amdgcn_mfma_f32_32x32x16_bf16(a, b, c, 0, 0, 0); }
DI f32x16 zero16() { f32x16 z;
#pragma unroll
    for (int i = 0; i < 16; ++i) z[i] = 0.f; return z; }
DI bf16x8 pack8(const f32x16& x, int s) {
    u32x4 p; p.x = pk2(x[8 * s + 0], x[8 * s + 1]); p.y = pk2(x[8 * s + 2], x[8 * s + 3]); p.z = pk2(x[8 * s + 4], x[8 * s + 5]); p.w = pk2(x[8 * s + 6], x[8 * s + 7]);
    return __builtin_bit_cast(bf16x8, p);
}
typedef short v4i16_t __attribute__((ext_vector_type(4)));
DI s16x4 vtr(LAS const unsigned char* p) { return __builtin_bit_cast(s16x4, __builtin_amdgcn_ds_read_tr16_b64_v4i16((LAS v4i16_t*)p)); }

struct EpiIn {
    static constexpr bool PERM = true, AFTER_DRAIN = false;
    unsigned char* ws; const float* lbl;
    DI void operator()(const f32x4 (&acc)[2][2][4][2], const Unit& u, int wr, int wc, int fr, int fq) const {
        const float* rinv = (const float*)(ws + WS_RINV); bf16_t* QB = (bf16_t*)(ws + WS_QB); bf16_t* G = (bf16_t*)(ws + WS_G); bf16_t* VB = (bf16_t*)(ws + WS_VB); bf16_t* GATE = (bf16_t*)(ws + WS_GATE);
        const int part = u.pn >> 2; const int cbase = (u.pn & 3) * 256 + wc * 32 + 8 * fq;
        float lb[2][8];
        if (part == 1) {
#pragma unroll
            for (int bj = 0; bj < 2; ++bj)
#pragma unroll
                for (int i = 0; i < 8; ++i) { const int c = cbase + bj * 128 + i; lb[bj][i] = fsigmoid(lbl[c] - lbl[1024 + c]); }
        }
#pragma unroll
        for (int ai = 0; ai < 2; ++ai)
#pragma unroll
            for (int m = 0; m < 4; ++m) {
                const int row = u.pm * 256 + ai * 128 + wr * 64 + m * 16 + fr; const float rs = rinv[row];
#pragma unroll
                for (int bj = 0; bj < 2; ++bj) {
                    const int c = cbase + bj * 128; float v[8];
#pragma unroll
                    for (int i = 0; i < 4; ++i) { v[i] = acc[ai][bj][m][0][i] * rs; v[4 + i] = acc[ai][bj][m][1][i] * rs; }
                    if (part == 1) {
                        f32x4 g0, g1;
#pragma unroll
                        for (int i = 0; i < 8; ++i) { const float f = lb[bj][i] + (1.f - lb[bj][i]) * fsigmoid(v[i]); const float g = __logf(f); if (i < 4) g0[i] = g; else g1[i - 4] = g; }
                        u32x4 w; w.x = pk2(g0[0], g0[1]); w.y = pk2(g0[2], g0[3]); w.z = pk2(g1[0], g1[1]); w.w = pk2(g1[2], g1[3]); *(u32x4*)(G + (size_t)row * 1024 + c) = w;
                    } else {
                        bf16_t* o = (part == 0 ? QB : (part == 2 ? VB : GATE)) + (size_t)row * 1024 + c;
                        if (part == 0) {
#pragma unroll
                            for (int i = 0; i < 8; ++i) v[i] = fsilu(v[i]) * QA_SCALE;
                        } else if (part == 3) {
#pragma unroll
                            for (int i = 0; i < 8; ++i) v[i] = fsilu(v[i]);
                        }
                        u32x4 w; w.x = pk2(v[0], v[1]); w.y = pk2(v[2], v[3]); w.z = pk2(v[4], v[5]); w.w = pk2(v[6], v[7]); *(u32x4*)o = w;
                    }
                }
            }
    }
};
struct EpiUp {
    static constexpr bool PERM = true, AFTER_DRAIN = false;
    unsigned char* ws;
    DI void operator()(const f32x4 (&acc)[2][2][4][2], const Unit& u, int wr, int wc, int fr, int fq) const {
        const float* rinv = (const float*)(ws + WS_RINV); bf16_t* HB = (bf16_t*)(ws + WS_HB);
        const int cbase = u.pn * 256 + wc * 32 + 8 * fq;
#pragma unroll
        for (int ai = 0; ai < 2; ++ai)
#pragma unroll
            for (int m = 0; m < 4; ++m) {
                const int row = u.pm * 256 + ai * 128 + wr * 64 + m * 16 + fr; const float rs = rinv[row];
#pragma unroll
                for (int bj = 0; bj < 2; ++bj) {
                    float v[8];
#pragma unroll
                    for (int i = 0; i < 4; ++i) { v[i] = acc[ai][bj][m][0][i] * rs; v[4 + i] = acc[ai][bj][m][1][i] * rs; }
#pragma unroll
                    for (int i = 0; i < 8; ++i) { const float t = fmaxf(v[i], 0.f); v[i] = t * t; }
                    u32x4 w; w.x = pk2(v[0], v[1]); w.y = pk2(v[2], v[3]); w.z = pk2(v[4], v[5]); w.w = pk2(v[6], v[7]);
                    *(u32x4*)(HB + (size_t)row * FF + cbase + bj * 128) = w;
                }
            }
    }
};
struct EpiMix {
    static constexpr bool PERM = true, AFTER_DRAIN = false;
    unsigned char* ws;
    DI void operator()(const f32x4 (&acc)[2][2][4][2], const Unit& u, int wr, int wc, int fr, int fq) const {
        bf16_t* MIXB = (bf16_t*)(ws + WS_MIXB);
        const int cbase = u.pn * 256 + wc * 32 + 8 * fq;
#pragma unroll
        for (int ai = 0; ai < 2; ++ai)
#pragma unroll
            for (int m = 0; m < 4; ++m) {
                const int row = u.pm * 256 + ai * 128 + wr * 64 + m * 16 + fr;
#pragma unroll
                for (int bj = 0; bj < 2; ++bj) {
                    const f32x4 a = acc[ai][bj][m][0], b = acc[ai][bj][m][1];
                    u32x4 w; w.x = pk2(a[0], a[1]); w.y = pk2(a[2], a[3]); w.z = pk2(b[0], b[1]); w.w = pk2(b[2], b[3]);
                    *(u32x4*)(MIXB + (size_t)row * 1024 + cbase + bj * 128) = w;
                }
            }
    }
};
struct EpiKvq {
    static constexpr bool PERM = true, AFTER_DRAIN = false;
    unsigned char* ws; float* out;
    DI void operator()(const f32x4 (&acc)[2][2][4][2], const Unit& u, int wr, int wc, int fr, int fq) const {
        const float* rinv = (const float*)(ws + WS_RINV); bf16_t* KB = (bf16_t*)(ws + WS_KB); bf16_t* VB2 = (bf16_t*)(ws + WS_VB2); bf16_t* QB2 = (bf16_t*)(ws + WS_QB); const float* COS = (const float*)(ws + WS_COS); const float* SIN = (const float*)(ws + WS_SIN);
        const int sec = u.pn < 2 ? 0 : (u.pn < 4 ? 1 : 2);
        const int cbase = u.pn * 256 + wc * 32 + 8 * fq;
        const bool rot = (sec != 1) && ((wc & 1) == 0);
#pragma unroll
        for (int ai = 0; ai < 2; ++ai)
#pragma unroll
            for (int m = 0; m < 4; ++m) {
                const int row = u.pm * 256 + ai * 128 + wr * 64 + m * 16 + fr; const float rs = rinv[row];
                const int pos = row < MP ? (row & 16383) : 4096 + ((row - MP) & 63);
                f32x4 c0, c1, s0, s1;
                if (rot) { c0 = *(const f32x4*)(COS + pos * 8); c1 = *(const f32x4*)(COS + pos * 8 + 4); s0 = *(const f32x4*)(SIN + pos * 8); s1 = *(const f32x4*)(SIN + pos * 8 + 4); }
#pragma unroll
                for (int bj = 0; bj < 2; ++bj) {
                    const int c = cbase + bj * 128; float v[8];
#pragma unroll
                    for (int i = 0; i < 4; ++i) { v[i] = acc[ai][bj][m][0][i] * rs; v[4 + i] = acc[ai][bj][m][1][i] * rs; }
                    if (rot) {
#pragma unroll
                        for (int i = 0; i < 8; ++i) {
                            const float pv = __shfl_xor(v[i], 16);
                            const float cs = i < 4 ? c0[i & 3] : c1[i & 3], sn = i < 4 ? s0[i & 3] : s1[i & 3];
                            const float r0 = v[i] * cs - pv * sn, r1 = v[i] * cs + pv * sn;
                            v[i] = fq == 0 ? r0 : (fq == 1 ? r1 : v[i]);
                        }
                    }
                    if (sec == 2) {
#pragma unroll
                        for (int i = 0; i < 8; ++i) v[i] *= QSCALE;
                        u32x4 w; w.x = pk2(v[0], v[1]); w.y = pk2(v[2], v[3]); w.z = pk2(v[4], v[5]); w.w = pk2(v[6], v[7]);
                        *(u32x4*)(QB2 + (size_t)row * 1024 + (c - 1024)) = w;
                    } else {
                        const int cc = sec == 0 ? c : c - 512;
                        float* o = out + (row < MP ? (sec == 0 ? O_KP : O_VP) + (size_t)row * 512 : (sec == 0 ? O_KS : O_VS) + (size_t)(row - MP) * 512) + cc;
                        *(f32x4*)o = (f32x4){v[0], v[1], v[2], v[3]}; *(f32x4*)(o + 4) = (f32x4){v[4], v[5], v[6], v[7]};
                        u32x4 w; w.x = pk2(v[0], v[1]); w.y = pk2(v[2], v[3]); w.z = pk2(v[4], v[5]); w.w = pk2(v[6], v[7]);
                        *(u32x4*)((sec == 0 ? KB : VB2) + (size_t)row * 512 + cc) = w;
                    }
                }
            }
    }
};

DI void transpose_item(const float* W, int K, int N, bf16_t* WT, int row_off, const float* gain, LAS float* scr, int item, int lane) {
    const int nblk = N / 32, kb = item / nblk, nb = item % nblk, k0 = 64 * kb, n0 = 32 * nb;
#pragma unroll
    for (int i = 0; i < 8; ++i) { const int kk = 8 * i + (lane >> 3), n4 = 4 * (lane & 7);
        f32x4 w = *(const f32x4*)(W + (size_t)(k0 + kk) * N + n0 + n4); if (gain) w = w * gain[k0 + kk];
        LAS float* sp = scr + kk * 33 + n4; sp[0] = w.x; sp[1] = w.y; sp[2] = w.z; sp[3] = w.w; }
    LDS_WAIT(); asm volatile("" ::: "memory");
    const int c = lane & 7;
#pragma unroll
    for (int j = 0; j < 4; ++j) { const int n = (lane >> 3) + 8 * j; const LAS float* s = scr + (8 * c) * 33 + n;
        u32x4 o; o.x = pk2(s[0 * 33], s[1 * 33]); o.y = pk2(s[2 * 33], s[3 * 33]); o.z = pk2(s[4 * 33], s[5 * 33]); o.w = pk2(s[6 * 33], s[7 * 33]);
        *(u32x4*)(WT + (size_t)(row_off + n0 + n) * K + k0 + 8 * c) = o; }
    LDS_WAIT(); asm volatile("" ::: "memory");
}
DI void phase0(const Params& p, ldsp lds, int tid, int lane, int wave, unsigned full) {
    unsigned char* ws = p.ws;
    if (blockIdx.x == 0) { unsigned* ctl = (unsigned*)(ws + WS_CTL); for (int i = tid; i < 8192; i += 512) ctl[i] = 0u; }
    if (!full) return;
    const int gw = blockIdx.x * 8 + wave, NGW = gridDim.x * 8;
    LAS float* scr = (LAS float*)(lds + wave * 16384);
    constexpr int I_A = 16 * 128, I_B = 16 * 32, I_C = 64 * 32;
    constexpr int NITEMS = 4 * I_A + 4 * I_B + 2 * I_C - I_A;
    static_assert(NITEMS == 3 * I_A + 4 * I_B + 2 * I_C, "items");
    for (int it = gw; it < NITEMS; it += NGW) {
        int r = it;
        if (r < I_A) { transpose_item(p.in[I_WIN], 1024, 4096, (bf16_t*)(ws + WS_WIN), 0, p.in[I_NMIXPRE], scr, r, lane); continue; } r -= I_A;
        if (r < I_A) { transpose_item(p.in[I_WUP], 1024, 4096, (bf16_t*)(ws + WS_WUP0), 0, p.in[I_NMLPPRE], scr, r, lane); continue; } r -= I_A;
        if (r < I_A) { transpose_item(p.in[I_WUP] + (size_t)1024 * 4096, 1024, 4096, (bf16_t*)(ws + WS_WUP1), 0, p.in[I_NMLPPRE] + 1024, scr, r, lane); continue; } r -= I_A;
        if (r < I_C) { transpose_item(p.in[I_WDOWN], 4096, 1024, (bf16_t*)(ws + WS_WDN0), 0, nullptr, scr, r, lane); continue; } r -= I_C;
        if (r < I_C) { transpose_item(p.in[I_WDOWN] + (size_t)4096 * 1024, 4096, 1024, (bf16_t*)(ws + WS_WDN1), 0, nullptr, scr, r, lane); continue; } r -= I_C;
        if (r < I_B) { transpose_item(p.in[I_WOA], 1024, 1024, (bf16_t*)(ws + WS_WOA), 0, nullptr, scr, r, lane); continue; } r -= I_B;
        if (r < I_B) { transpose_item(p.in[I_WKV], 1024, 1024, (bf16_t*)(ws + WS_WKVQ), 0, p.in[I_NKV], scr, r, lane); continue; } r -= I_B;
        if (r < I_B) { transpose_item(p.in[I_WQ], 1024, 1024, (bf16_t*)(ws + WS_WKVQ), 1024, p.in[I_NMIXPRE] + 1024, scr, r, lane); continue; } r -= I_B;
        transpose_item(p.in[I_WOB], 1024, 1024, (bf16_t*)(ws + WS_WOB), 0, nullptr, scr, r, lane);
    }
    float* RINV = (float*)(ws + WS_RINV); bf16_t* XB = (bf16_t*)(ws + WS_XB);
    for (int m = gw; m < M; m += NGW) {
        const float* xr = m < MP ? p.in[I_XP] + (size_t)m * 1024 : p.in[I_XS] + (size_t)(m - MP) * 1024;
        f32x4 v[4]; float s = 0.f;
#pragma unroll
        for (int j = 0; j < 4; ++j) { v[j] = ((const f32x4*)xr)[lane + 64 * j]; s += (v[j].x * v[j].x + v[j].y * v[j].y) + (v[j].z * v[j].z + v[j].w * v[j].w); }
        s = wave_sum(s);
        if (lane == 0) RINV[m] = rsqrtf(s * (1.f / 1024.f) + EPS);
        u32x2* o = (u32x2*)(XB + (size_t)m * 1024) + lane;
#pragma unroll
        for (int j = 0; j < 4; ++j) { u32x2 w; w.x = pk2(v[j].x, v[j].y); w.y = pk2(v[j].z, v[j].w); o[64 * j] = w; }
    }
    float* COS = (float*)(ws + WS_COS); float* SIN = (float*)(ws + WS_SIN);
    for (int i = blockIdx.x * 512 + tid; i < 16384 * 8; i += gridDim.x * 512) {
        const int pos = i >> 3, d = i & 7;
        const double f = d == 0 ? 1.0 : d == 1 ? 0.19392274474868576 : d == 2 ? 0.03760603093086393 : d == 3 ? 0.007292664737217109 : d == 4 ? 0.001414213562373095 : d == 5 ? 0.0002742481756762073 : d == 6 ? 5.318295896944988e-05 : 1.031338537721246e-05;
        const float invf = (float)f;
        const float angf = (float)pos * invf;
        const double rev = (double)angf * 0.15915494309189535;
        const float fr = (float)(rev - __builtin_floor(rev));
        COS[i] = __builtin_amdgcn_cosf(fr); SIN[i] = __builtin_amdgcn_sinf(fr);
    }
}

template <bool FIRST, bool LAST> DI void thin_phase(const Params& p, const float* gpost, int lane, int wave) {
    unsigned char* ws = p.ws;
    const int gw = blockIdx.x * 8 + wave, NGW = gridDim.x * 8;
    float* RINV = (float*)(ws + WS_RINV); bf16_t* XB = (bf16_t*)(ws + WS_XB); const bf16_t* MIXB = (const bf16_t*)(ws + WS_MIXB); float* Y = p.out + O_Y;
    f32x4 gp[4];
#pragma unroll
    for (int j = 0; j < 4; ++j) gp[j] = ((const f32x4*)gpost)[lane + 64 * j];
    for (int m = gw; m < M; m += NGW) {
        const u32x2* mx = (const u32x2*)(MIXB + (size_t)m * 1024) + lane;
        f32x4 mv[4], hv[4]; float s = 0.f;
        if (FIRST) {
            const float* hr = m < MP ? p.in[I_XP] + (size_t)m * 1024 : p.in[I_XS] + (size_t)(m - MP) * 1024;
#pragma unroll
            for (int j = 0; j < 4; ++j) hv[j] = ((const f32x4*)hr)[lane + 64 * j];
        } else {
            const u32x2* hx = (const u32x2*)(XB + (size_t)m * 1024) + lane;
#pragma unroll
            for (int j = 0; j < 4; ++j) { const u32x2 w = hx[64 * j]; hv[j] = (f32x4){bflo(w.x), bfhi(w.x), bflo(w.y), bfhi(w.y)}; }
        }
        if (m < MP) {
#pragma unroll
            for (int j = 0; j < 4; ++j) { const u32x2 w = mx[64 * j]; mv[j] = (f32x4){bflo(w.x), bfhi(w.x), bflo(w.y), bfhi(w.y)}; }
        } else {
            const f32x4* pp = (const f32x4*)((const float*)(ws + WS_QB) + (size_t)(m - MP) * 1024) + lane;
#pragma unroll
            for (int j = 0; j < 4; ++j) { f32x4 a = pp[64 * j];
#pragma unroll
                for (int ks = 1; ks < 8; ++ks) a = a + pp[(size_t)ks * 2048 * 256 + 64 * j];
                mv[j] = a; }
        }
#pragma unroll
        for (int j = 0; j < 4; ++j) s += (mv[j].x * mv[j].x + mv[j].y * mv[j].y) + (mv[j].z * mv[j].z + mv[j].w * mv[j].w);
        s = wave_sum(s);
        const float r1 = rsqrtf(s * (1.f / 1024.f) + EPS);
#pragma unroll
        for (int j = 0; j < 4; ++j) hv[j] = hv[j] + mv[j] * r1 * gp[j];
        if (LAST) {
#pragma unroll
            for (int j = 0; j < 4; ++j) ((f32x4*)(Y + (size_t)m * 1024))[lane + 64 * j] = hv[j];
        } else {
            u32x2 w[4]; float s2 = 0.f;
#pragma unroll
            for (int j = 0; j < 4; ++j) { w[j].x = pk2(hv[j].x, hv[j].y); w[j].y = pk2(hv[j].z, hv[j].w);
                const float a = bflo(w[j].x), b = bfhi(w[j].x), c = bflo(w[j].y), d = bfhi(w[j].y); s2 += (a * a + b * b) + (c * c + d * d); }
            s2 = wave_sum(s2);
            if (lane == 0) RINV[m] = rsqrtf(s2 * (1.f / 1024.f) + EPS);
            u32x2* o = (u32x2*)(XB + (size_t)m * 1024) + lane;
#pragma unroll
            for (int j = 0; j < 4; ++j) o[64 * j] = w[j];
        }
    }
}

DI void hgrn_a(const Params& p, ldsp lds, int tid, int lane, int wave) {
    unsigned char* ws = p.ws;
    const bf16_t* G = (const bf16_t*)(ws + WS_G); const bf16_t* VB = (const bf16_t*)(ws + WS_VB); float* RU = (float*)(ws + WS_UT); float* RD = (float*)(ws + WS_DEC);
    LAS float* TOT = (LAS float*)(lds + 36864); LAS float* DECL = (LAS float*)(lds + 38912);
    const int d = tid & 127, tq = tid >> 7, r = lane & 31, h = lane >> 5, bm = wave >> 1;
    u32x4 rg[2], rv[2];
#define HA_LOAD(u_) do { const int cg_ = (u_) >> 3, hh_ = (u_) & 7; \
        _Pragma("unroll") for (int k = 0; k < 2; ++k) { const int idx_ = tid + 512 * k; const size_t o_ = (size_t)(cg_ * 64 + (idx_ >> 4)) * 1024 + hh_ * 128 + (idx_ & 15) * 8; \
            rg[k] = *(const u32x4*)(G + o_); rv[k] = *(const u32x4*)(VB + o_); } } while (0)
    for (int run = blockIdx.x; run < 256; run += gridDim.x) {
        const int bh = run >> 4, rr = run & 15, hh = bh & 7, cg0 = (bh >> 3) * 256 + rr * 16;
        f32x16 S[2]; S[0] = zero16(); S[1] = zero16(); float bsum = 0.f;
        HA_LOAD(cg0 * 8 + hh);
        for (int ci = 0; ci < 16; ++ci) {
            const int cgi = cg0 + ci;
#pragma unroll
            for (int k = 0; k < 2; ++k) { const int idx = tid + 512 * k, off = (idx >> 4) * 272 + (idx & 15) * 16; *(LAS u32x4*)(lds + 40960 + off) = rg[k]; *(LAS u32x4*)(lds + 58368 + off) = rv[k]; }
            __syncthreads();
            float gv[16]; unsigned short vv[16];
#pragma unroll
            for (int i = 0; i < 16; ++i) { const int e = ((16 * tq + i) * 136 + d) * 2; gv[i] = bf2f(*(const LAS unsigned short*)(lds + 40960 + e)); vv[i] = *(const LAS unsigned short*)(lds + 58368 + e); }
            float bl[16], kk[16];
            { float c = 0.f;
#pragma unroll
              for (int i = 0; i < 16; ++i) { kk[i] = 1.f - __expf(gv[i]); c += gv[i]; bl[i] = c; }
              TOT[tq * 128 + d] = c; }
            { u32x4 x0, x1;
              x0.x = vv[0] | ((unsigned)vv[1] << 16); x0.y = vv[2] | ((unsigned)vv[3] << 16); x0.z = vv[4] | ((unsigned)vv[5] << 16); x0.w = vv[6] | ((unsigned)vv[7] << 16);
              x1.x = vv[8] | ((unsigned)vv[9] << 16); x1.y = vv[10] | ((unsigned)vv[11] << 16); x1.z = vv[12] | ((unsigned)vv[13] << 16); x1.w = vv[14] | ((unsigned)vv[15] << 16);
              *(LAS u32x4*)(lds + 18432 + d * 144 + tq * 32) = x0; *(LAS u32x4*)(lds + 18432 + d * 144 + tq * 32 + 16) = x1; }
            if (ci + 1 < 16) HA_LOAD((cgi + 1) * 8 + hh);
            __syncthreads();
            float off = 0.f, blast = 0.f;
#pragma unroll
            for (int j = 0; j < 4; ++j) { const float t = TOT[j * 128 + d]; blast += t; if (j < tq) off += t; }
            { u32x4 w0, w1; float e[16];
#pragma unroll
              for (int i = 0; i < 16; ++i) e[i] = kk[i] * __expf(blast - (bl[i] + off));
              w0.x = pk2(e[0], e[1]); w0.y = pk2(e[2], e[3]); w0.z = pk2(e[4], e[5]); w0.w = pk2(e[6], e[7]); w1.x = pk2(e[8], e[9]); w1.y = pk2(e[10], e[11]); w1.z = pk2(e[12], e[13]); w1.w = pk2(e[14], e[15]);
              *(LAS u32x4*)(lds + d * 144 + tq * 32) = w0; *(LAS u32x4*)(lds + d * 144 + tq * 32 + 16) = w1; }
            if (tq == 0) { DECL[d] = __expf(blast); bsum += blast; }
            __syncthreads();
#pragma unroll
            for (int q = 0; q < 2; ++q) {
                const int bn = 2 * (wave & 1) + q; const float dc = DECL[32 * bn + r];
                f32x16 acc = S[q] * dc;
#pragma unroll
                for (int ks = 0; ks < 4; ++ks) {
                    const bf16x8 a = *(const LAS bf16x8*)(lds + 18432 + (32 * bm + r) * 144 + (16 * ks + 8 * h) * 2);
                    const bf16x8 b = *(const LAS bf16x8*)(lds + (32 * bn + r) * 144 + (16 * ks + 8 * h) * 2);
                    acc = mfma32(a, b, acc);
                }
                S[q] = acc;
            }
            __syncthreads();
        }
#pragma unroll
        for (int q = 0; q < 2; ++q)
#pragma unroll
            for (int g4 = 0; g4 < 4; ++g4) *(f32x4*)(RU + (size_t)run * 16384 + ((wave * 2 + q) * 4 + g4) * 256 + lane * 4) = (f32x4){S[q][4 * g4], S[q][4 * g4 + 1], S[q][4 * g4 + 2], S[q][4 * g4 + 3]};
        if (tq == 0) RD[run * 128 + d] = __expf(bsum);
    }
#undef HA_LOAD
}
DI void hgrn_c(const Params& p, ldsp lds, int tid, int lane, int wave) {
    unsigned char* ws = p.ws;
    const bf16_t* G = (const bf16_t*)(ws + WS_G); const bf16_t* VB = (const bf16_t*)(ws + WS_VB); const bf16_t* QB = (const bf16_t*)(ws + WS_QB); const bf16_t* GATE = (const bf16_t*)(ws + WS_GATE);
    const float* RU = (const float*)(ws + WS_UT); const float* RD = (const float*)(ws + WS_DEC); bf16_t* OB = (bf16_t*)(ws + WS_OB); const float* gn = p.in[I_GNORM];
    LAS float* TOT = (LAS float*)(lds + 105472); LAS float* RED = (LAS float*)(lds + 107520); LAS float* DECL = (LAS float*)(lds + 126976);
    LAS bf16_t* QT = (LAS bf16_t*)(lds); LAS bf16_t* KT = (LAS bf16_t*)(lds + 17408); LAS bf16_t* QH = (LAS bf16_t*)(lds + 34816); LAS bf16_t* STl = (LAS bf16_t*)(lds + 70656);
    const int d = tid & 127, tq = tid >> 7, r = lane & 31, h = lane >> 5;
    const int dvb = wave & 3, tb = wave >> 2, bm = wave >> 1;
    u32x4 rg[2], rv[2], rq[2];
#define HC_LOAD(u_) do { const int cg_ = (u_) >> 3, hh_ = (u_) & 7; \
        _Pragma("unroll") for (int k = 0; k < 2; ++k) { const int idx_ = tid + 512 * k; const size_t o_ = (size_t)(cg_ * 64 + (idx_ >> 4)) * 1024 + hh_ * 128 + (idx_ & 15) * 8; \
            rg[k] = *(const u32x4*)(G + o_); rv[k] = *(const u32x4*)(VB + o_); rq[k] = *(const u32x4*)(QB + o_); } } while (0)
    for (int run = blockIdx.x; run < 512; run += gridDim.x) {
        const bool smp = run >= 256;
        int hh, cg0, nch, sidx, rr = 0;
        if (!smp) { const int bh = run >> 4; rr = run & 15; hh = bh & 7; cg0 = (bh >> 3) * 256 + rr * 16; nch = 16; sidx = bh; }
        else { const int bs = (run - 256) >> 3; hh = run & 7; cg0 = NCHP + bs; nch = 1; sidx = bs * 8 + hh; }
        HC_LOAD(cg0 * 8 + hh);
        f32x16 S[2];
        if (smp) {
#pragma unroll
            for (int q = 0; q < 2; ++q) { const int dk = 32 * (2 * (wave & 1) + q) + r; const float* sp = p.in[I_STATE] + ((size_t)sidx * 128 + dk) * 128;
#pragma unroll
                for (int g4 = 0; g4 < 4; ++g4) { const f32x4 v = *(const f32x4*)(sp + 32 * bm + 8 * g4 + 4 * h); S[q][4 * g4] = v.x; S[q][4 * g4 + 1] = v.y; S[q][4 * g4 + 2] = v.z; S[q][4 * g4 + 3] = v.w; } }
        } else {
            S[0] = zero16(); S[1] = zero16();
            for (int j = 0; j < rr; ++j) { const int rj = (run & ~15) + j;
#pragma unroll
                for (int q = 0; q < 2; ++q) { const int dk = 32 * (2 * (wave & 1) + q) + r; const float dc = RD[rj * 128 + dk];
#pragma unroll
                    for (int g4 = 0; g4 < 4; ++g4) { const f32x4 u = *(const f32x4*)(RU + (size_t)rj * 16384 + ((wave * 2 + q) * 4 + g4) * 256 + lane * 4);
                        S[q][4 * g4] = dc * S[q][4 * g4] + u.x; S[q][4 * g4 + 1] = dc * S[q][4 * g4 + 1] + u.y; S[q][4 * g4 + 2] = dc * S[q][4 * g4 + 2] + u.z; S[q][4 * g4 + 3] = dc * S[q][4 * g4 + 3] + u.w; } } }
        }
        for (int ci = 0; ci < nch; ++ci) {
            const int cgi = cg0 + ci, row0 = cgi * 64;
            const size_t orow = (size_t)(row0 + 32 * tb + r) * 1024 + hh * 128;
            u32x2 gt[4];
#pragma unroll
            for (int g4 = 0; g4 < 4; ++g4) gt[g4] = *(const u32x2*)(GATE + orow + 32 * dvb + 8 * g4 + 4 * h);
#pragma unroll
            for (int k = 0; k < 2; ++k) { const int idx = tid + 512 * k, off = (idx >> 4) * 272 + (idx & 15) * 16; *(LAS u32x4*)(lds + off) = rq[k]; *(LAS u32x4*)(lds + 17408 + off) = rg[k]; *(LAS u32x4*)(lds + 34816 + off) = rv[k]; }
            __syncthreads();
            float gv[16]; unsigned short vv[16], qq[16];
#pragma unroll
            for (int i = 0; i < 16; ++i) { const int e = ((16 * tq + i) * 136 + d) * 2; qq[i] = *(const LAS unsigned short*)(lds + e); gv[i] = bf2f(*(const LAS unsigned short*)(lds + 17408 + e)); vv[i] = *(const LAS unsigned short*)(lds + 34816 + e); }
            float bl[16];
            { float c = 0.f;
#pragma unroll
              for (int i = 0; i < 16; ++i) { c += gv[i]; bl[i] = c; }
              TOT[tq * 128 + d] = c; }
#pragma unroll
            for (int q = 0; q < 2; ++q) { const int dk = 32 * (2 * (wave & 1) + q) + r;
#pragma unroll
                for (int reg = 0; reg < 16; ++reg) STl[(32 * bm + crow(reg, h)) * 136 + dk] = f2bf(S[q][reg]); }
            __syncthreads();
            { float off = 0.f, blast = 0.f;
#pragma unroll
              for (int j = 0; j < 4; ++j) { const float t = TOT[j * 128 + d]; blast += t; if (j < tq) off += t; }
              const float bmid = TOT[d] + TOT[128 + d]; float e[16];
#pragma unroll
              for (int i = 0; i < 16; ++i) { const int t = 16 * tq + i; const float bt = bl[i] + off, kk = 1.f - __expf(gv[i]), qv = bf2f(qq[i]);
                  QT[t * 136 + d] = f2bf(qv * __expf(bt - bmid)); KT[t * 136 + d] = f2bf(kk * __expf(bmid - bt)); QH[t * 136 + d] = f2bf(qv * __expf(bt)); e[i] = kk * __expf(blast - bt); }
              u32x4 w0, w1;
              w0.x = pk2(e[0], e[1]); w0.y = pk2(e[2], e[3]); w0.z = pk2(e[4], e[5]); w0.w = pk2(e[6], e[7]); w1.x = pk2(e[8], e[9]); w1.y = pk2(e[10], e[11]); w1.z = pk2(e[12], e[13]); w1.w = pk2(e[14], e[15]);
              *(LAS u32x4*)(lds + 108544 + d * 144 + tq * 32) = w0; *(LAS u32x4*)(lds + 108544 + d * 144 + tq * 32 + 16) = w1;
              if (tq == 0) DECL[d] = __expf(blast);
              u32x4 x0, x1;
              x0.x = vv[0] | ((unsigned)vv[1] << 16); x0.y = vv[2] | ((unsigned)vv[3] << 16); x0.z = vv[4] | ((unsigned)vv[5] << 16); x0.w = vv[6] | ((unsigned)vv[7] << 16);
              x1.x = vv[8] | ((unsigned)vv[9] << 16); x1.y = vv[10] | ((unsigned)vv[11] << 16); x1.z = vv[12] | ((unsigned)vv[13] << 16); x1.w = vv[14] | ((unsigned)vv[15] << 16);
              *(LAS u32x4*)(lds + 52224 + d * 144 + tq * 32) = x0; *(LAS u32x4*)(lds + 52224 + d * 144 + tq * 32 + 16) = x1; }
            if (ci + 1 < nch) HC_LOAD((cgi + 1) * 8 + hh);
            __syncthreads();
            f32x16 o = zero16();
            for (int sb = 0; sb <= tb; ++sb) {
                f32x16 sc = zero16();
#pragma unroll
                for (int ks = 0; ks < 8; ++ks) {
                    const bf16x8 a = *(const LAS bf16x8*)(lds + 17408 + (32 * sb + r) * 272 + (16 * ks + 8 * h) * 2);
                    const bf16x8 b = *(const LAS bf16x8*)(lds + (32 * tb + r) * 272 + (16 * ks + 8 * h) * 2);
                    sc = mfma32(a, b, sc);
                }
                if (sb == tb) {
#pragma unroll
                    for (int reg = 0; reg < 16; ++reg) if (crow(reg, h) > r) sc[reg] = 0.f;
                }
#pragma unroll
                for (int s2 = 0; s2 < 2; ++s2) {
                    const int kb = 32 * sb + 16 * s2 + 4 * h;
                    const s16x4 lo = *(const LAS s16x4*)(lds + 52224 + (32 * dvb + r) * 144 + kb * 2);
                    const s16x4 hi = *(const LAS s16x4*)(lds + 52224 + (32 * dvb + r) * 144 + (kb + 8) * 2);
                    const bf16x8 a = (bf16x8){lo[0], lo[1], lo[2], lo[3], hi[0], hi[1], hi[2], hi[3]};
                    o = mfma32(a, pack8(sc, s2), o);
                }
            }
#pragma unroll
            for (int ks = 0; ks < 8; ++ks) {
                const bf16x8 a = *(const LAS bf16x8*)(lds + 70656 + (32 * dvb + r) * 272 + (16 * ks + 8 * h) * 2);
                const bf16x8 b = *(const LAS bf16x8*)(lds + 34816 + (32 * tb + r) * 272 + (16 * ks + 8 * h) * 2);
                o = mfma32(a, b, o);
            }
#pragma unroll
            for (int q = 0; q < 2; ++q) {
                const int bn = 2 * (wave & 1) + q; const float dc = DECL[32 * bn + r];
                f32x16 acc = S[q] * dc;
#pragma unroll
                for (int ks = 0; ks < 4; ++ks) {
                    const bf16x8 a = *(const LAS bf16x8*)(lds + 52224 + (32 * bm + r) * 144 + (16 * ks + 8 * h) * 2);
                    const bf16x8 b = *(const LAS bf16x8*)(lds + 108544 + (32 * bn + r) * 144 + (16 * ks + 8 * h) * 2);
                    acc = mfma32(a, b, acc);
                }
                S[q] = acc;
            }
            float ssq = 0.f;
#pragma unroll
            for (int reg = 0; reg < 16; ++reg) ssq += o[reg] * o[reg];
            ssq += __shfl_xor(ssq, 32);
            if (h == 0) RED[(tb * 4 + dvb) * 32 + r] = ssq;
            __syncthreads();
            const float tot = (RED[(tb * 4 + 0) * 32 + r] + RED[(tb * 4 + 1) * 32 + r]) + (RED[(tb * 4 + 2) * 32 + r] + RED[(tb * 4 + 3) * 32 + r]);
            const float rn = rsqrtf(tot * (1.f / 128.f) + EPS);
#pragma unroll
            for (int g4 = 0; g4 < 4; ++g4) { const int dv0 = 32 * dvb + 8 * g4 + 4 * h;
                const f32x4 gg = *(const f32x4*)(gn + dv0);
                u32x2 w; w.x = pk2(o[4 * g4] * rn * gg.x * bflo(gt[g4].x), o[4 * g4 + 1] * rn * gg.y * bfhi(gt[g4].x)); w.y = pk2(o[4 * g4 + 2] * rn * gg.z * bflo(gt[g4].y), o[4 * g4 + 3] * rn * gg.w * bfhi(gt[g4].y));
                *(u32x2*)(OB + orow + dv0) = w; }
            __syncthreads();
        }
        if (smp || rr == 15) {
            float* so = p.out + (smp ? O_SS : O_SP) + (size_t)sidx * 16384;
#pragma unroll
            for (int q = 0; q < 2; ++q) { const int dk = 32 * (2 * (wave & 1) + q) + r;
#pragma unroll
                for (int g4 = 0; g4 < 4; ++g4) *(f32x4*)(so + (size_t)dk * 128 + 32 * bm + 8 * g4 + 4 * h) = (f32x4){S[q][4 * g4], S[q][4 * g4 + 1], S[q][4 * g4 + 2], S[q][4 * g4 + 3]}; }
        }
    }
#undef HC_LOAD
}

constexpr int A_KB0 = 0, A_KBS = 17408, A_VB0 = 34816, A_VBS = 20480, A_ITEM = 76800;
DI void a_ld_bf(u32x4& a, u32x4& b, const bf16_t* T, int rowbase, int kvh, int tid) {
    const int k0 = tid >> 4, c8 = tid & 15;
    a = *(const u32x4*)(T + (size_t)(rowbase + k0) * 512 + kvh * 128 + c8 * 8); b = *(const u32x4*)(T + (size_t)(rowbase + 32 + k0) * 512 + kvh * 128 + c8 * 8);
}
DI void a_st_bf(ldsp buf, int stride, const u32x4& a, const u32x4& b, int tid) {
    const int k0 = tid >> 4, c8 = tid & 15;
    *(LAS u32x4*)(buf + k0 * stride + c8 * 16) = a; *(LAS u32x4*)(buf + (32 + k0) * stride + c8 * 16) = b;
}
DI void a_ld_f32(u32x4 (&st)[4], const float* C, int ctile, int tid) {
    const int k0 = tid >> 5, c4 = tid & 31;
#pragma unroll
    for (int i = 0; i < 4; ++i) st[i] = *(const u32x4*)(C + (size_t)(ctile * 64 + 16 * i + k0) * 512 + c4 * 4);
}
DI void a_st_f32(ldsp buf, int stride, const u32x4 (&st)[4], int tid) {
    const int k0 = tid >> 5, c4 = tid & 31;
#pragma unroll
    for (int i = 0; i < 4; ++i) { u32x2 w; w.x = pk2(__uint_as_float(st[i].x), __uint_as_float(st[i].y)); w.y = pk2(__uint_as_float(st[i].z), __uint_as_float(st[i].w));
        *(LAS u32x2*)(buf + (16 * i + k0) * stride + c4 * 8) = w; }
}
DI void a_qk(f32x16& p0, f32x16& p1, ldsp kb, int koff, const bf16x8 (&qr)[4]) {
    const f32x16 z = zero16();
#pragma unroll
    for (int d0 = 0; d0 < 4; ++d0) {
        const bf16x8 a0 = *(const LAS bf16x8*)(kb + koff + d0 * 32);
        const bf16x8 a1 = *(const LAS bf16x8*)(kb + koff + 32 * 272 + d0 * 32);
        p0 = mfma32(a0, qr[d0], d0 ? p0 : z); p1 = mfma32(a1, qr[d0], d0 ? p1 : z);
    }
}
DI float a_rowmax(const f32x16& p0, const f32x16& p1) {
    float a = fmaxf(fmaxf(p0[0], p0[1]), p1[0]), b = fmaxf(fmaxf(p0[2], p0[3]), p1[1]), c = fmaxf(fmaxf(p0[4], p0[5]), p1[2]), d = fmaxf(fmaxf(p0[6], p0[7]), p1[3]);
    a = fmaxf(fmaxf(a, p0[8]), p1[4]); b = fmaxf(fmaxf(b, p0[9]), p1[5]); c = fmaxf(fmaxf(c, p0[10]), p1[6]); d = fmaxf(fmaxf(d, p0[11]), p1[7]);
    a = fmaxf(fmaxf(a, p0[12]), p1[8]); b = fmaxf(fmaxf(b, p0[13]), p1[9]); c = fmaxf(fmaxf(c, p0[14]), p1[10]); d = fmaxf(fmaxf(d, p0[15]), p1[11]);
    a = fmaxf(fmaxf(a, p1[12]), p1[13]); b = fmaxf(fmaxf(b, p1[14]), p1[15]);
    float m = fmaxf(fmaxf(a, b), fmaxf(c, d));
    return fmaxf(m, __shfl_xor(m, 32));
}
struct AttnCtx { int tid, kvh, kbase, bs, nt; const float* ckp; const float* cvp; const bf16_t* KB; const bf16_t* VB2; int koff, tr_off, h; };
constexpr int F_KB0 = 0, F_KBS = 17408, F_VB0 = 34816, F_VBS = 20480;
DI void a_unit_fp(const Params& p, const AttnCtx& c, ldsp lds, f32x16 (&o)[4], const bf16x8 (&qr)[4], float& mrun, float& lrun, int mm, int lane) {
    const int tid = c.tid, kvh = c.kvh, kbase = c.kbase, bs = c.bs, ncache = 64, nt = 65, r = lane & 31, h = lane >> 5;
    const bf16_t* KB = c.KB; const bf16_t* VB2 = c.VB2;
    const int tr_off = (((lane & 15) >> 2)) * 320 + (16 * ((lane >> 4) & 1) + 4 * (lane & 3)) * 2;
    constexpr int A_KB0 = F_KB0, A_KBS = F_KBS, A_VB0 = F_VB0, A_VBS = F_VBS;
        mrun = -1e30f; lrun = 0.f;
        u32x4 st[8];
        const float* ckp = p.in[I_CK] + ((size_t)bs * 4096 * 4 + kvh) * 128; const float* cvp = p.in[I_CV] + ((size_t)bs * 4096 * 4 + kvh) * 128;
#define A_LOAD(t) do { if ((t) < ncache) { _Pragma("unroll") for (int i_ = 0; i_ < 4; ++i_) { const int key_ = tid >> 3, c4_ = (tid & 7) * 4 + i_; const size_t so_ = (size_t)((t) * 64 + key_) * 512 + c4_ * 4; \
                st[i_] = *(const u32x4*)(ckp + so_); st[4 + i_] = *(const u32x4*)(cvp + so_); } } \
            else { _Pragma("unroll") for (int i_ = 0; i_ < 2; ++i_) { const int key_ = tid >> 3, c8_ = (tid & 7) * 2 + i_; const size_t so_ = (size_t)(kbase + ((t) - ncache) * 64 + key_) * 512 + kvh * 128 + c8_ * 8; \
                st[i_] = *(const u32x4*)(KB + so_); st[2 + i_] = *(const u32x4*)(VB2 + so_); } } } while (0)
#define A_STORE(t) do { const int kb_ = A_KB0 + ((t) & 1) * A_KBS, vb_ = A_VB0 + ((t) & 1) * A_VBS; \
            if ((t) < ncache) { _Pragma("unroll") for (int i_ = 0; i_ < 4; ++i_) { const int key_ = tid >> 3, c4_ = (tid & 7) * 4 + i_; \
                u32x2 a_, b_; a_.x = pk2(__uint_as_float(st[i_].x), __uint_as_float(st[i_].y)); a_.y = pk2(__uint_as_float(st[i_].z), __uint_as_float(st[i_].w)); \
                b_.x = pk2(__uint_as_float(st[4 + i_].x), __uint_as_float(st[4 + i_].y)); b_.y = pk2(__uint_as_float(st[4 + i_].z), __uint_as_float(st[4 + i_].w)); \
                *(LAS u32x2*)(lds + kb_ + key_ * 272 + c4_ * 8) = a_; *(LAS u32x2*)(lds + vb_ + key_ * 320 + c4_ * 8) = b_; } } \
            else { _Pragma("unroll") for (int i_ = 0; i_ < 2; ++i_) { const int key_ = tid >> 3, c8_ = (tid & 7) * 2 + i_; \
                *(LAS u32x4*)(lds + kb_ + key_ * 272 + c8_ * 16) = st[i_]; *(LAS u32x4*)(lds + vb_ + key_ * 320 + c8_ * 16) = st[2 + i_]; } } } while (0)
        A_LOAD(0);
        A_STORE(0);
        __syncthreads();
        for (int t = 0; t < nt; ++t) {
            if (t + 1 < nt) A_LOAD(t + 1);
            const int kb = A_KB0 + (t & 1) * A_KBS, vb = A_VB0 + (t & 1) * A_VBS;
            f32x16 p0 = zero16(), p1 = zero16();
#pragma unroll
            for (int d0 = 0; d0 < 4; ++d0) {
                const bf16x8 a0 = *(const LAS bf16x8*)(lds + kb + r * 272 + (mm * 64 + 16 * d0 + 8 * h) * 2);
                const bf16x8 a1 = *(const LAS bf16x8*)(lds + kb + (32 + r) * 272 + (mm * 64 + 16 * d0 + 8 * h) * 2);
                p0 = mfma32(a0, qr[d0], p0); p1 = mfma32(a1, qr[d0], p1);
            }
            float mx = fmaxf(p0[0], p1[0]);
#pragma unroll
            for (int i = 1; i < 16; ++i) mx = fmaxf(mx, fmaxf(p0[i], p1[i]));
            mx = fmaxf(mx, __shfl_xor(mx, 32));
            if (__any(mx > mrun + 8.f)) {
                const float mn = fmaxf(mrun, mx), al = __builtin_amdgcn_exp2f(mrun - mn);
                lrun *= al; mrun = mn;
#pragma unroll
                for (int i = 0; i < 4; ++i)
#pragma unroll
                    for (int j = 0; j < 16; ++j) o[i][j] *= al;
            }
            float ls = 0.f;
#pragma unroll
            for (int i = 0; i < 16; ++i) { p0[i] = __builtin_amdgcn_exp2f(p0[i] - mrun); p1[i] = __builtin_amdgcn_exp2f(p1[i] - mrun); ls += p0[i] + p1[i]; }
            lrun += ls;
            bf16x8 pk[4]; pk[0] = pack8(p0, 0); pk[1] = pack8(p0, 1); pk[2] = pack8(p1, 0); pk[3] = pack8(p1, 1);
#pragma unroll
            for (int s = 0; s < 4; ++s) {
                const int keyb = 32 * (s >> 1) + 16 * (s & 1) + 4 * h;
#pragma unroll
                for (int db = 0; db < 4; ++db) {
                    const s16x4 lo = vtr(lds + vb + keyb * 320 + db * 64 + tr_off);
                    const s16x4 hi = vtr(lds + vb + (keyb + 8) * 320 + db * 64 + tr_off);
                    const bf16x8 a = (bf16x8){lo[0], lo[1], lo[2], lo[3], hi[0], hi[1], hi[2], hi[3]};
                    o[db] = mfma32(a, pk[s], o[db]);
                }
            }
            if (t + 1 < nt) A_STORE(t + 1);
            __syncthreads();
        }
#undef A_LOAD
#undef A_STORE
}
constexpr int B_K0 = 0, B_V0 = 32768, B_TS = 16384;
DI void a_dma_tile(ldsp dst, const bf16_t* T, int rowbase, int kvh, int wave, int lane, bool isV) {
#pragma unroll
    for (int i = 0; i < 2; ++i) {
        const int j = wave + 8 * i, row = 4 * j + (lane >> 4), pc = lane & 15, cch = isV ? (pc ^ ((row & 3) << 2)) : (pc ^ (row & 15));
        __builtin_amdgcn_global_load_lds((const unsigned*)(T + (size_t)(rowbase + row) * 512 + kvh * 128 + cch * 8), (LAS unsigned*)(dst + j * 1024), 16, 0, 0);
    }
}
DI void b_qk(f32x16& p0, f32x16& p1, ldsp kb, int koff, const bf16x8 (&qr)[4], const f32x16& z) {
#pragma unroll
    for (int d0 = 0; d0 < 4; ++d0) {
        const bf16x8 a0 = *(const LAS bf16x8*)(kb + (koff ^ (d0 * 32)));
        const bf16x8 a1 = *(const LAS bf16x8*)(kb + (koff ^ (d0 * 32)) + 8192);
        p0 = mfma32(a0, qr[d0], d0 ? p0 : z); p1 = mfma32(a1, qr[d0], d0 ? p1 : z);
    }
}
#define SB() __builtin_amdgcn_sched_barrier(0)
DI void b_vfrag(s16x4 (&f)[8], ldsp vb, const int (&trb)[4], int s) {
    const int kimm = (32 * (s >> 1) + 16 * (s & 1)) * 256;
#pragma unroll
    for (int db = 0; db < 4; ++db) { f[2 * db] = vtr(vb + trb[db] + kimm); f[2 * db + 1] = vtr(vb + trb[db] + kimm + 8 * 256); }
}
DI void b_pv(f32x16 (&o)[4], const s16x4 (&f)[8], bf16x8 pk) {
#pragma unroll
    for (int db = 0; db < 4; ++db) { const s16x4 lo = f[2 * db], hi = f[2 * db + 1];
        o[db] = mfma32((bf16x8){lo[0], lo[1], lo[2], lo[3], hi[0], hi[1], hi[2], hi[3]}, pk, o[db]); }
}
DI void b_step(const AttnCtx& c, ldsp lds, int wave, int lane, int t, f32x16& S0, f32x16& S1, f32x16& N0, f32x16& N1, f32x16 (&o)[4], const bf16x8 (&qr)[4], const int (&trb)[4], f32x16& negm, float& lrun) {
    const int tK = min(t + 2, c.nt - 1), tV = min(t + 1, c.nt - 1);
    const bool hasN = t + 1 < c.nt;
    a_dma_tile(lds + B_K0 + (t & 1) * B_TS, c.KB, c.kbase + tK * 64, c.kvh, wave, lane, false);
    a_dma_tile(lds + B_V0 + ((t + 1) & 1) * B_TS, c.VB2, c.kbase + tV * 64, c.kvh, wave, lane, true);
    const ldsp kb = lds + B_K0 + ((t + 1) & 1) * B_TS, vb = lds + B_V0 + (t & 1) * B_TS;
    bf16x8 ka[4], kc[4]; s16x4 f0[8], f1[8]; bf16x8 pk0, pk1, pk2, pk3; float ls = 0.f;
    ka[0] = *(const LAS bf16x8*)(kb + c.koff); ka[1] = *(const LAS bf16x8*)(kb + c.koff + 8192); ka[2] = *(const LAS bf16x8*)(kb + (c.koff ^ 32)); ka[3] = *(const LAS bf16x8*)(kb + (c.koff ^ 32) + 8192);
    SB();
    N0 = mfma32(ka[0], qr[0], negm); N1 = mfma32(ka[1], qr[0], negm); N0 = mfma32(ka[2], qr[1], N0); N1 = mfma32(ka[3], qr[1], N1);
    kc[0] = *(const LAS bf16x8*)(kb + (c.koff ^ 64)); kc[1] = *(const LAS bf16x8*)(kb + (c.koff ^ 64) + 8192); kc[2] = *(const LAS bf16x8*)(kb + (c.koff ^ 96)); kc[3] = *(const LAS bf16x8*)(kb + (c.koff ^ 96) + 8192);
#pragma unroll
    for (int i = 0; i < 16; ++i) { S0[i] = __builtin_amdgcn_exp2f(S0[i]); ls += S0[i]; }
    SB();
    N0 = mfma32(kc[0], qr[2], N0); N1 = mfma32(kc[1], qr[2], N1); N0 = mfma32(kc[2], qr[3], N0); N1 = mfma32(kc[3], qr[3], N1);
    b_vfrag(f0, vb, trb, 0);
    pk0 = pack8(S0, 0); pk1 = pack8(S0, 1);
#pragma unroll
    for (int i = 0; i < 8; ++i) { S1[i] = __builtin_amdgcn_exp2f(S1[i]); ls += S1[i]; }
    SB();
    __builtin_amdgcn_s_setprio(1);
    b_pv(o, f0, pk0);
    b_vfrag(f1, vb, trb, 1);
#pragma unroll
    for (int i = 8; i < 16; ++i) { S1[i] = __builtin_amdgcn_exp2f(S1[i]); ls += S1[i]; }
    SB();
    b_pv(o, f1, pk1);
    b_vfrag(f0, vb, trb, 2);
    pk2 = pack8(S1, 0); pk3 = pack8(S1, 1);
    lrun += ls;
    SB();
    b_pv(o, f0, pk2);
    b_vfrag(f1, vb, trb, 3);
    float mx = a_rowmax(N0, N1); mx = hasN ? mx : -1e30f;
    SB();
    b_pv(o, f1, pk3);
    __builtin_amdgcn_s_setprio(0);
    SB();
    if (__any(mx > 8.f)) {
        const float dl = fmaxf(mx, 0.f), al = __builtin_amdgcn_exp2f(-dl);
        lrun *= al;
#pragma unroll
        for (int i = 0; i < 4; ++i)
#pragma unroll
            for (int j = 0; j < 16; ++j) o[i][j] *= al;
#pragma unroll
        for (int j = 0; j < 16; ++j) { N0[j] -= dl; N1[j] -= dl; negm[j] -= dl; }
    }
    __syncthreads();
}
DI void a_unit_bf(const AttnCtx& c, ldsp lds, int wave, int lane, int mm, f32x16 (&o)[4], const bf16x8 (&qr)[4], float& mrun, float& lrun) {
    const int r = lane & 31, h = lane >> 5, q = (lane & 15) >> 2, pp = lane & 3, g16 = (lane >> 4) & 1;
    int trb[4];
#pragma unroll
    for (int db = 0; db < 4; ++db) trb[db] = (4 * h + q) * 256 + (4 * (db ^ q) + 2 * g16 + (pp >> 1)) * 16 + 8 * (pp & 1);
    AttnCtx cc = c; cc.koff = r * 256 + (((8 * mm + h) ^ (r & 15)) * 16);
    a_dma_tile(lds + B_K0, c.KB, c.kbase, c.kvh, wave, lane, false);
    a_dma_tile(lds + B_V0, c.VB2, c.kbase, c.kvh, wave, lane, true);
    a_dma_tile(lds + B_K0 + B_TS, c.KB, c.kbase + min(1, c.nt - 1) * 64, c.kvh, wave, lane, false);
    __syncthreads();
    f32x16 A0, A1, B0, B1, negm;
    b_qk(A0, A1, lds + B_K0, cc.koff, qr, zero16());
    mrun = a_rowmax(A0, A1); lrun = 0.f;
#pragma unroll
    for (int j = 0; j < 16; ++j) { A0[j] -= mrun; A1[j] -= mrun; negm[j] = -mrun; }
    for (int t = 0; t < c.nt; t += 2) {
        b_step(cc, lds, wave, lane, t, A0, A1, B0, B1, o, qr, trb, negm, lrun);
        if (t + 1 < c.nt) b_step(cc, lds, wave, lane, t + 1, B0, B1, A0, A1, o, qr, trb, negm, lrun);
    }
}
DI void attn_phase(const Params& p, ldsp lds, int tid0, int lane0, int wave) {
    unsigned char* ws = p.ws;
    const bf16_t* QB2 = (const bf16_t*)(ws + WS_QB); bf16_t* OB = (bf16_t*)(ws + WS_OB);
    unsigned* qhead = (unsigned*)(ws + WS_CTL);
    const int th = wave & 1, g = (wave >> 1) & 1, mm = wave >> 2;
    const int x = blockIdx.x & 7;
    float lam;
    { const float a = p.in[I_LQ1][lane0] * p.in[I_LK1][lane0], b = p.in[I_LQ2][lane0] * p.in[I_LK2][lane0]; lam = __expf(wave_sum(a)) - __expf(wave_sum(b)) + LAM_INIT; }
    for (;;) {
        int lane = lane0; asm volatile("" : "+v"(lane));
        const int tid = (wave << 6) | lane, r = lane & 31, h = lane >> 5;
        AttnCtx c; c.tid = tid; c.h = h; c.KB = (const bf16_t*)(ws + WS_KB); c.VB2 = (const bf16_t*)(ws + WS_VB2); c.koff = 0; c.tr_off = 0;
        if (tid == 0) *(LAS unsigned*)(lds + A_ITEM) = __hip_atomic_fetch_add(qhead + x * 64, 1u, __ATOMIC_RELAXED, __HIP_MEMORY_SCOPE_AGENT);
        __syncthreads();
        const int item = (int)*(LAS unsigned*)(lds + A_ITEM);
        if (item >= 16 + 256) break;
        int qrow0; bool fp;
        if (item < 16) { c.bs = x * 4 + (item >> 2); c.kvh = item & 3; qrow0 = MP + c.bs * 64; c.kbase = qrow0; fp = true; c.nt = 65; }
        else { const int b = x >> 2, qc = 255 - (item - 16); c.bs = 0; c.kvh = x & 3; qrow0 = b * 16384 + qc * 64; c.kbase = b * 16384; fp = false; c.nt = qc + 1; }
        c.ckp = p.in[I_CK] + ((size_t)c.bs * 4096 * 4 + c.kvh) * 128; c.cvp = p.in[I_CV] + ((size_t)c.bs * 4096 * 4 + c.kvh) * 128;
        const int hq = c.kvh * 2 + g;
        bf16x8 qr[4];
        { const bf16_t* qp = QB2 + (size_t)(qrow0 + 32 * th + r) * 1024 + hq * 128 + mm * 64 + 8 * h;
#pragma unroll
          for (int d0 = 0; d0 < 4; ++d0) qr[d0] = *(const bf16x8*)(qp + 16 * d0); }
        f32x16 o[4];
#pragma unroll
        for (int i = 0; i < 4; ++i) o[i] = zero16();
        float mrun, lrun;
        if (fp) a_unit_fp(p, c, lds, o, qr, mrun, lrun, mm, lane); else a_unit_bf(c, lds, wave, lane, mm, o, qr, mrun, lrun);
        lrun += __shfl_xor(lrun, 32);
        const float inv = __builtin_amdgcn_rcpf(lrun);
        LAS float* cmb = (LAS float*)(lds) + (size_t)(g * 2 + th) * 4096 + lane;
        if (mm == 1) {
            const float sc = lam * inv;
#pragma unroll
            for (int i = 0; i < 4; ++i)
#pragma unroll
                for (int j = 0; j < 16; ++j) cmb[(i * 16 + j) * 64] = o[i][j] * sc;
        }
        __syncthreads();
        if (mm == 0) {
            float ssq = 0.f;
#pragma unroll
            for (int i = 0; i < 4; ++i)
#pragma unroll
                for (int j = 0; j < 16; ++j) { const float v = o[i][j] * inv - cmb[(i * 16 + j) * 64]; o[i][j] = v; ssq += v * v; }
            ssq += __shfl_xor(ssq, 32);
            const float rn = rsqrtf(ssq * (1.f / 128.f) + EPS) * (1.f - LAM_INIT);
            bf16_t* op = OB + (size_t)(qrow0 + 32 * th + r) * 1024 + hq * 128;
#pragma unroll
            for (int i = 0; i < 4; ++i)
#pragma unroll
                for (int g4 = 0; g4 < 4; ++g4) { const int dv0 = 32 * i + 8 * g4 + 4 * h; const f32x4 gg = *(const f32x4*)(p.in[I_SUBLN] + dv0);
                    u32x2 w; w.x = pk2(o[i][4 * g4] * rn * gg.x, o[i][4 * g4 + 1] * rn * gg.y); w.y = pk2(o[i][4 * g4 + 2] * rn * gg.z, o[i][4 * g4 + 3] * rn * gg.w);
                    *(u32x2*)(op + dv0) = w; }
        }
        __syncthreads();
    }
}

#define XB_TMO      128
#define XB_XCNT(j)  (256  + 64 * (j))
#define XB_XSUB(j)  (1280 + 64 * (j))
#define XB_XGEN(j)  (2304 + 64 * (j))
#define XB_TOP      3328
#define XB_TOPGEN   3392
#define XCD_BAR_WORDS 3456
#define XB_SPIN_CAP (1u << 18)

__device__ __forceinline__ unsigned xb_ld(unsigned* p)              { return __hip_atomic_load(p, __ATOMIC_RELAXED, __HIP_MEMORY_SCOPE_AGENT); }
__device__ __forceinline__ unsigned xb_add(unsigned* p, unsigned v) { return __hip_atomic_fetch_add(p, v, __ATOMIC_RELAXED, __HIP_MEMORY_SCOPE_AGENT); }
__device__ __forceinline__ unsigned xb_xcc_id() { return (unsigned)__builtin_amdgcn_s_getreg((3 << 11) | 20) & 0xFu; }
#define XB_SPIN(cond, bar) do { unsigned _sp = 0; while (cond) { __builtin_amdgcn_s_sleep(1); \
    if ((++_sp & 255u) == 0u) { if (xb_ld(&(bar)[XB_TMO])) break; if (_sp > XB_SPIN_CAP) { atomicAdd(&(bar)[XB_TMO], 1u); break; } } } } while (0)

struct XcdBarrier {
    unsigned* bar; unsigned x;
    volatile LAS unsigned* st;
};

__device__ __forceinline__ XcdBarrier xcd_barrier_post(unsigned* bar, volatile LAS unsigned* st) {
    XcdBarrier b; b.bar = bar; b.x = xb_xcc_id(); b.st = st;
    if (threadIdx.x == 0) (void)xb_add(&bar[XB_XCNT(b.x)], 1u);
    return b;
}
__device__ __forceinline__ void xcd_barrier_complete(unsigned* bar, unsigned x, unsigned& nloc, unsigned& nx) {
    const unsigned G = gridDim.x * gridDim.y * gridDim.z;
    unsigned sum, cnt, mine, sp = 0u;
    for (;;) {
        sum = 0u; cnt = 0u; mine = 0u;
#pragma unroll
        for (unsigned j = 0; j < 16; ++j) { const unsigned c = xb_ld(&bar[XB_XCNT(j)]); sum += c; cnt += (c > 0u) ? 1u : 0u; mine = (j == x) ? c : mine; }
        if (sum == G) break;
        __builtin_amdgcn_s_sleep(1);
        if ((++sp & 255u) == 0u) { if (xb_ld(&bar[XB_TMO])) break; if (sp > XB_SPIN_CAP) { atomicAdd(&bar[XB_TMO], 1u); break; } }
    }
    nloc = mine > 0u ? mine : 1u; nx = cnt > 0u ? cnt : 1u;
}

__device__ __forceinline__ void xcd_barrier(const XcdBarrier& b) {
    asm volatile("s_waitcnt vmcnt(0)" ::: "memory");
    __syncthreads();
    if (threadIdx.x == 0) {
        unsigned* bar = b.bar;
        __builtin_amdgcn_s_waitcnt(0);
        unsigned nloc = b.st[0], nx = b.st[1];
        if (nloc == 0u) { xcd_barrier_complete(bar, b.x, nloc, nx); b.st[0] = nloc; b.st[1] = nx; }
        const unsigned old = xb_add(&bar[XB_XSUB(b.x)], 1u);
        const unsigned gen = old / nloc;
        if (old + 1u == (gen + 1u) * nloc) {
            __builtin_amdgcn_fence(__ATOMIC_RELEASE, "agent");
            asm volatile("s_waitcnt vmcnt(0)" ::: "memory");
            const unsigned og = xb_add(&bar[XB_TOP], 1u);
            const unsigned tg = og / nx;
            if (og + 1u == (tg + 1u) * nx) xb_add(&bar[XB_TOPGEN], 1u);
            else XB_SPIN(xb_ld(&bar[XB_TOPGEN]) == tg, bar);
            __builtin_amdgcn_fence(__ATOMIC_ACQUIRE, "agent");
            xb_add(&bar[XB_XGEN(b.x)], 1u);
            asm volatile("s_waitcnt vmcnt(0)" ::: "memory");
        } else {
            XB_SPIN(xb_ld(&bar[XB_XGEN(b.x)]) == gen, bar);
            __builtin_amdgcn_fence(__ATOMIC_ACQUIRE, "agent");
            asm volatile("s_waitcnt vmcnt(0)" ::: "memory");
        }
    }
    __syncthreads();
}

struct SplitSched {
    int G, c;
    DI bool next(int i, Unit& u) const { const int L = i * G + c; if (L >= 256) return false; u.ko = (L & 7); u.pn = (L >> 3) & 3; u.pm = 128 + (L >> 5); return true; }
    DI void a_ready(const Unit&) const {}
    DI void done(const Unit&) const {}
};
struct EpiPart {
    static constexpr bool PERM = true, AFTER_DRAIN = false;
    float* PART; int kslice;
    DI void operator()(const f32x4 (&acc)[2][2][4][2], const Unit& u, int wr, int wc, int fr, int fq) const {
        const int cbase = u.pn * 256 + wc * 32 + 8 * fq; float* base = PART + (size_t)(u.ko / kslice) * 2048 * 1024;
#pragma unroll
        for (int ai = 0; ai < 2; ++ai)
#pragma unroll
            for (int m = 0; m < 4; ++m) {
                const int row = (u.pm - 128) * 256 + ai * 128 + wr * 64 + m * 16 + fr;
#pragma unroll
                for (int bj = 0; bj < 2; ++bj) { float* o = base + (size_t)row * 1024 + cbase + bj * 128; *(f32x4*)o = acc[ai][bj][m][0]; *(f32x4*)(o + 4) = acc[ai][bj][m][1]; }
            }
    }
};
struct SplitSchedK {
    int G, c, kslice;
    DI bool next(int i, Unit& u) const { const int L = i * G + c; if (L >= 256) return false; u.ko = (L & 7) * kslice; u.pn = (L >> 3) & 3; u.pm = 128 + (L >> 5); return true; }
    DI void a_ready(const Unit&) const {}
    DI void done(const Unit&) const {}
};
DI void run_gemm_mix(ldsp lds, unsigned char* ws, const bf16_t* A, const bf16_t* Bt, int K) {
    { pg8::Gemm g{A, Bt, MP, 1024, K, K}; pg8::StaticOrder S; S.init(MP, 1024, (int)gridDim.x, (int)blockIdx.x); EpiMix E{ws};
      pg8::gemm_phase<EpiMix, pg8::StaticOrder, true, true>(lds, g, S, E); }
    { pg8::Gemm g{A, Bt, M, 1024, K / 8, K}; SplitSchedK S{(int)gridDim.x, (int)blockIdx.x, K / 8}; EpiPart E{(float*)(ws + WS_QB), K / 8};
      pg8::gemm_phase<EpiPart, SplitSchedK, false, true>(lds, g, S, E); }
}
template <class Epi> DI void run_gemm(ldsp lds, const bf16_t* A, const bf16_t* Bt, int N, int K, const Epi& E) {
    pg8::Gemm g{A, Bt, M, N, K, K}; pg8::StaticOrder S; S.init(M, N, (int)gridDim.x, (int)blockIdx.x);
    pg8::gemm_phase<Epi, pg8::StaticOrder, true, true>(lds, g, S, E);
}
#ifndef MK_LAST_PHASE
#define MK_LAST_PHASE 99
#endif
__global__ void __launch_bounds__(512, 2) yoco_fwd(Params p) {
    extern __shared__ __attribute__((aligned(16))) unsigned char lds_raw[];
    cg::grid_group grid = cg::this_grid();
    ldsp lds = (ldsp)lds_raw;
    const int tid = threadIdx.x, lane = tid & 63, wave = __builtin_amdgcn_readfirstlane(tid >> 6);
    unsigned char* ws = p.ws;
    float* RINV = (float*)(ws + WS_RINV); bf16_t* XB = (bf16_t*)(ws + WS_XB); bf16_t* MIXB = (bf16_t*)(ws + WS_MIXB); bf16_t* OB = (bf16_t*)(ws + WS_OB); bf16_t* HB = (bf16_t*)(ws + WS_HB);
#define SEAM(k) xcd_barrier(bar)
#define PH(k) ((p.mask >> (k)) & 1u)
    volatile LAS unsigned* xst = (volatile LAS unsigned*)(lds + 147200);
    if (tid < 2) xst[tid] = 0u;
    phase0(p, lds, tid, lane, wave, PH(0));
    grid.sync();
    XcdBarrier bar = xcd_barrier_post((unsigned*)(ws + WS_CTL) + 4096, xst);
    if (PH(1)) { EpiIn E{ws, p.in[I_LB]}; run_gemm(lds, XB, (const bf16_t*)(ws + WS_WIN), 4096, 1024, E); }
    SEAM(1);
    if (PH(2)) hgrn_a(p, lds, tid, lane, wave);
    SEAM(2);
    if (PH(4)) hgrn_c(p, lds, tid, lane, wave);
    SEAM(4);
    if (PH(5)) run_gemm_mix(lds, ws, OB, (const bf16_t*)(ws + WS_WOA), 1024);
    SEAM(5);
    if (PH(6)) thin_phase<false, false>(p, p.in[I_NMIXPOST], lane, wave);
    SEAM(6);
    if (PH(7)) { EpiUp E{ws}; run_gemm(lds, XB, (const bf16_t*)(ws + WS_WUP0), 4096, 1024, E); }
    SEAM(7);
    if (PH(8)) run_gemm_mix(lds, ws, HB, (const bf16_t*)(ws + WS_WDN0), 4096);
    SEAM(8);
    if (PH(9)) thin_phase<false, false>(p, p.in[I_NMLPPOST], lane, wave);
    SEAM(9);
    if (PH(10)) { EpiKvq E{ws, p.out}; run_gemm(lds, XB, (const bf16_t*)(ws + WS_WKVQ), 2048, 1024, E); }
    SEAM(10);
    if (PH(11)) attn_phase(p, lds, tid, lane, wave);
    SEAM(11);
    if (PH(12)) run_gemm_mix(lds, ws, OB, (const bf16_t*)(ws + WS_WOB), 1024);
    SEAM(12);
    if (PH(13)) thin_phase<false, false>(p, p.in[I_NMIXPOST] + 1024, lane, wave);
    SEAM(13);
    if (PH(14)) { EpiUp E{ws}; run_gemm(lds, XB, (const bf16_t*)(ws + WS_WUP1), 4096, 1024, E); }
    SEAM(14);
    if (PH(15)) run_gemm_mix(lds, ws, HB, (const bf16_t*)(ws + WS_WDN1), 4096);
    SEAM(15);
    if (PH(16)) thin_phase<false, true>(p, p.in[I_NMLPPOST] + 1024, lane, wave);
#undef PH
#undef SEAM
}
}

extern "C" void kernel_launch(void* const* d_in, const int* in_sizes, int n_in, void* d_out, int out_size, void* d_ws, size_t ws_size, hipStream_t stream) {
    static int grid = 0;
    if (grid == 0) {
        if (n_in != 24 || ws_size < mk::WS_END) { fprintf(stderr, "kernel_launch: need 24 inputs and >= %zu bytes of workspace; got %d, %zu\n", (size_t)mk::WS_END, n_in, ws_size); grid = -1; return; }
        int dev = 0, cus = 0, per_cu = 0;
        if (hipGetDevice(&dev) != hipSuccess || hipDeviceGetAttribute(&cus, hipDeviceAttributeMultiprocessorCount, dev) != hipSuccess) { grid = -1; return; }
        if (hipFuncSetAttribute((const void*)mk::yoco_fwd, hipFuncAttributeMaxDynamicSharedMemorySize, mk::LDS_BYTES) != hipSuccess) { fprintf(stderr, "kernel_launch: hipFuncSetAttribute failed\n"); grid = -1; return; }
        if (hipOccupancyMaxActiveBlocksPerMultiprocessor(&per_cu, (const void*)mk::yoco_fwd, 512, mk::LDS_BYTES) != hipSuccess || per_cu < 1) { fprintf(stderr, "kernel_launch: occupancy query says %d\n", per_cu); per_cu = 1; }
        (void)hipGetLastError();
        grid = cus;
    }
    if (grid < 0) return;
    mk::Params prm{};
    for (int i = 0; i < 24; ++i) prm.in[i] = (const float*)d_in[i];
    prm.out = (float*)d_out; prm.ws = (unsigned char*)d_ws;
#if defined(MK_PROBE_MASK)
    { prm.mask = MK_PROBE_MASK; void* pa[] = {&prm}; (void)hipLaunchCooperativeKernel((const void*)mk::yoco_fwd, dim3(grid), dim3(512), pa, mk::LDS_BYTES, stream); }
#endif
    prm.mask = 0x1ffffu;
    void* args[] = {&prm};
    hipError_t e = hipLaunchCooperativeKernel((const void*)mk::yoco_fwd, dim3(grid), dim3(512), args, mk::LDS_BYTES, stream);
    if (e != hipSuccess) fprintf(stderr, "kernel_launch: cooperative launch failed: %s (grid %d)\n", hipGetErrorString(e), grid);
}
```
